# Optimizing an MI355X kernel written in HIP

```python
import math
import jax, jax.numpy as jnp
from jax import lax
import numpy as np

D_MODEL = 1024
BATCH = 8
SEQ = 2048
DEPTH = 2

CHUNK = 64
N_A = DEPTH // 2
N_B = DEPTH - N_A
H_A = 8
DK_A = D_MODEL // H_A
DV_A = D_MODEL // H_A
QK_A = H_A * DK_A
V_A = H_A * DV_A
CONV_W = 4
A_IN = 2 * QK_A + 2 * V_A + 2 * H_A
H_B = 8
DH_B = D_MODEL // (2 * H_B)
QK_B = H_B * 2 * DH_B
V_B = H_B * 2 * DH_B
Q_BLOCK = 128
N_EXPERTS = 32
TOP_K = 4
D_EXPERT = D_MODEL
SWIGLU_LIMIT = 7.0
SWIGLU_ALPHA = 1.702
MOE_BLOCK = 256
EPS = 1e-6

kernel_name = "hybrid_deltanet_diffattn_moe_yoco"


def rms_norm(t):
    t32 = t.astype(jnp.float32)
    return t32 * lax.rsqrt(jnp.mean(t32 * t32, axis=-1, keepdims=True) + EPS)


def l2_normalize(t):
    return t * lax.rsqrt(jnp.sum(t * t, axis=-1, keepdims=True) + EPS)


def modulate(h, shift, scale):
    y = rms_norm(h) * (1.0 + scale[:, None, :].astype(jnp.float32)) + shift[:, None, :].astype(jnp.float32)
    return y.astype(h.dtype)


def causal_depthwise_conv(t, w):
    width = w.shape[0]
    return lax.conv_general_dilated(
        t, w[:, None, :].astype(t.dtype), window_strides=(1,), padding=[(width - 1, 0)],
        dimension_numbers=("NWC", "WIO", "NWC"), feature_group_count=t.shape[-1])


def chunk_gated_delta_rule(q, k, v, g, beta):
    bsz, seq, nh, dk = q.shape
    dv = v.shape[-1]
    nc = seq // CHUNK

    def chunks(t):
        t = jnp.moveaxis(t, 2, 1)
        return t.reshape((bsz, nh, nc, CHUNK) + t.shape[3:])

    q, k, v, g, beta = (chunks(t) for t in (q, k, v, g, beta))
    g = jnp.cumsum(g, axis=-1)
    idx = jnp.arange(CHUNK)
    incl = idx[:, None] >= idx[None, :]
    strict = idx[:, None] > idx[None, :]
    diff = g[..., :, None] - g[..., None, :]
    decay = jnp.where(incl, jnp.exp(jnp.where(incl, diff, 0.0)), 0.0)
    k_beta = k * beta[..., None]
    v_beta = v * beta[..., None]
    l_mat = jnp.where(strict, jnp.einsum('bhncd,bhnjd->bhncj', k_beta, k) * decay, 0.0)
    a_mat = l_mat + jnp.eye(CHUNK, dtype=l_mat.dtype)

    def solve(rhs):
        return lax.linalg.triangular_solve(a_mat, rhs, left_side=True, lower=True, unit_diagonal=True)

    u = solve(v_beta)
    w = solve(k_beta * jnp.exp(g)[..., None])
    qk = jnp.einsum('bhncd,bhnjd->bhncj', q, k) * decay
    q_dec = q * jnp.exp(g)[..., None]
    k_dec = k * jnp.exp(g[..., -1:] - g)[..., None]
    g_last = jnp.exp(g[..., -1])

    def step(state, xs):
        u_c, w_c, qk_c, q_c, k_c, gl_c = xs
        v_new = u_c - jnp.einsum('bhcd,bhde->bhce', w_c, state)
        o_c = jnp.einsum('bhcd,bhde->bhce', q_c, state) + jnp.einsum('bhcj,bhje->bhce', qk_c, v_new)
        state = state * gl_c[..., None, None] + jnp.einsum('bhcd,bhce->bhde', k_c, v_new)
        return state, o_c

    xs = tuple(jnp.moveaxis(t, 2, 0) for t in (u, w, qk, q_dec, k_dec, g_last))
    state0 = jnp.zeros((bsz, nh, dk, dv), jnp.float32)
    _, o = lax.scan(step, state0, xs)
    o = jnp.transpose(o, (1, 0, 3, 2, 4))
    return o.reshape(bsz, seq, nh, dv)


def gated_deltanet(xn, w_in, conv_w, a_log, dt_bias, norm_w, w_out):
    bsz, seq, _ = xn.shape
    proj = xn @ w_in
    n_qkv = 2 * QK_A + V_A
    qkv = jax.nn.silu(causal_depthwise_conv(proj[..., :n_qkv], conv_w)).astype(jnp.float32)
    z = proj[..., n_qkv:n_qkv + V_A].reshape(bsz, seq, H_A, DV_A)
    b_logit = proj[..., n_qkv + V_A:n_qkv + V_A + H_A].astype(jnp.float32)
    a_in = proj[..., n_qkv + V_A + H_A:].astype(jnp.float32)
    q = l2_normalize(qkv[..., :QK_A].reshape(bsz, seq, H_A, DK_A)) * (DK_A ** -0.5)
    k = l2_normalize(qkv[..., QK_A:2 * QK_A].reshape(bsz, seq, H_A, DK_A))
    v = qkv[..., 2 * QK_A:].reshape(bsz, seq, H_A, DV_A)
    beta = jax.nn.sigmoid(b_logit)
    g = -jnp.exp(a_log.astype(jnp.float32)) * jax.nn.softplus(a_in + dt_bias.astype(jnp.float32))
    o = chunk_gated_delta_rule(q, k, v, g, beta)
    o = rms_norm(o) * norm_w.astype(jnp.float32) * jax.nn.silu(z.astype(jnp.float32))
    return o.reshape(bsz, seq, V_A).astype(xn.dtype) @ w_out


def shared_kv(h, c_act, kv_ada_w, kv_ada_b, w_k, w_v, k_norm):
    bsz, seq, _ = h.shape
    shift, scale = jnp.split(c_act @ kv_ada_w + kv_ada_b, 2, axis=-1)
    hkv = modulate(h, shift, scale)
    k = rms_norm((hkv @ w_k).reshape(bsz, seq, H_B, 2, DH_B)) * k_norm.astype(jnp.float32)
    v = (hkv @ w_v).reshape(bsz, seq, H_B, 2 * DH_B).astype(jnp.float32)
    return k, v


def diff_attention(xn, k, v, w_q, q_norm, lam_q1, lam_k1, lam_q2, lam_k2, subln, w_out, lambda_init):
    bsz, seq, _ = xn.shape
    q = rms_norm((xn @ w_q).reshape(bsz, seq, H_B, 2, DH_B)) * q_norm.astype(jnp.float32) * (DH_B ** -0.5)
    lam = (jnp.exp(jnp.sum(lam_q1.astype(jnp.float32) * lam_k1.astype(jnp.float32)))
           - jnp.exp(jnp.sum(lam_q2.astype(jnp.float32) * lam_k2.astype(jnp.float32))) + lambda_init)
    nqb = seq // Q_BLOCK
    q_blocks = jnp.moveaxis(q.reshape(bsz, nqb, Q_BLOCK, H_B, 2, DH_B), 1, 0)
    k_chunk = jnp.arange(seq) // CHUNK

    def block(args):
        q_blk, bi = args
        s = jnp.einsum('bqhmd,bkhmd->bhmqk', q_blk, k)
        q_chunk = (bi * Q_BLOCK + jnp.arange(Q_BLOCK)) // CHUNK
        allowed = k_chunk[None, :] <= q_chunk[:, None]
        p = jax.nn.softmax(jnp.where(allowed, s, -1e30), axis=-1)
        a = p[:, :, 0] - lam * p[:, :, 1]
        return jnp.einsum('bhqk,bkhe->bqhe', a, v)

    o = lax.map(block, (q_blocks, jnp.arange(nqb)))
    o = jnp.moveaxis(o, 0, 1).reshape(bsz, seq, H_B, 2 * DH_B)
    o = rms_norm(o) * subln.astype(jnp.float32) * (1.0 - lambda_init)
    return o.reshape(bsz, seq, V_B).astype(xn.dtype) @ w_out


def clamped_swiglu(h_gate, h_up):
    g = jnp.minimum(h_gate, SWIGLU_LIMIT)
    u = jnp.clip(h_up, -SWIGLU_LIMIT, SWIGLU_LIMIT)
    return g * jax.nn.sigmoid(SWIGLU_ALPHA * g) * (u + 1.0)


def moe_ffn(xn, w_router, b_router, w_gate, b_gate, w_up, b_up, w_down, b_down):
    bsz, seq, d = xn.shape
    xt = xn.reshape(-1, d)
    n_tok = xt.shape[0]
    logits = (xt @ w_router + b_router).astype(jnp.float32)
    top_val, top_idx = lax.top_k(logits, TOP_K)
    gates = jax.nn.softmax(top_val, axis=-1)
    e_flat = top_idx.reshape(-1)
    g_flat = gates.reshape(-1)
    t_flat = jnp.arange(n_tok * TOP_K) // TOP_K
    order = jnp.argsort(e_flat)
    e_sorted = e_flat[order]
    counts = jnp.zeros((N_EXPERTS,), jnp.int32).at[e_flat].add(1)
    padded = (counts + MOE_BLOCK - 1) // MOE_BLOCK * MOE_BLOCK
    start = jnp.cumsum(counts) - counts
    pend = jnp.cumsum(padded)
    pstart = pend - padded
    dest = pstart[e_sorted] + (jnp.arange(n_tok * TOP_K) - start[e_sorted])
    n_blocks = (n_tok * TOP_K + N_EXPERTS * (MOE_BLOCK - 1) + MOE_BLOCK - 1) // MOE_BLOCK
    n_rows = n_blocks * MOE_BLOCK
    row_tok = jnp.zeros((n_rows,), jnp.int32).at[dest].set(t_flat[order])
    row_gate = jnp.zeros((n_rows,), jnp.float32).at[dest].set(g_flat[order])
    block_expert = jnp.minimum(
        jnp.searchsorted(pend, jnp.arange(n_blocks) * MOE_BLOCK, side='right'), N_EXPERTS - 1)

    def run_block(args):
        toks, e = args
        xb = xt[toks]
        hid = clamped_swiglu(xb @ w_gate[e] + b_gate[e], xb @ w_up[e] + b_up[e])
        return hid @ w_down[e] + b_down[e]

    ys = lax.map(run_block, (row_tok.reshape(n_blocks, MOE_BLOCK), block_expert))
    ys = (ys.reshape(n_rows, d) * row_gate[:, None]).astype(xt.dtype)
    out = jnp.zeros((n_tok, d), xt.dtype).at[row_tok].add(ys)
    return out.reshape(bsz, seq, d)


def _normal(k, shape, scale):
    return jax.random.normal(k, shape, jnp.float32) * scale


def setup_inputs(seed: int = 0) -> dict:
    key = jax.random.key(seed)
    ks = iter(jax.random.split(key, 40))
    D = D_MODEL
    x = _normal(next(ks), (BATCH, SEQ, D), 1.0)
    c = _normal(next(ks), (BATCH, D), 1.0)
    ada_w = _normal(next(ks), (DEPTH, D, 6 * D), D ** -0.5)
    ada_b = _normal(next(ks), (DEPTH, 6 * D), 0.02)
    a_w_in = _normal(next(ks), (N_A, D, A_IN), D ** -0.5)
    a_conv = _normal(next(ks), (N_A, CONV_W, 2 * QK_A + V_A), CONV_W ** -0.5)
    a_log = jnp.log(jax.random.uniform(next(ks), (N_A, H_A), jnp.float32, 1.0, 16.0))
    dt = jnp.exp(jax.random.uniform(next(ks), (N_A, H_A), jnp.float32, math.log(1e-3), math.log(1e-1)))
    a_dt_bias = dt + jnp.log(-jnp.expm1(-dt))
    a_norm = 1.0 + _normal(next(ks), (N_A, DV_A), 0.02)
    a_w_out = _normal(next(ks), (N_A, V_A, D), V_A ** -0.5)
    kv_ada_w = _normal(next(ks), (D, 2 * D), D ** -0.5)
    kv_ada_b = _normal(next(ks), (2 * D,), 0.02)
    b_w_k = _normal(next(ks), (D, QK_B), D ** -0.5)
    b_w_v = _normal(next(ks), (D, V_B), D ** -0.5)
    b_k_norm = 1.0 + _normal(next(ks), (DH_B,), 0.02)
    b_w_q = _normal(next(ks), (N_B, D, QK_B), D ** -0.5)
    b_q_norm = 1.0 + _normal(next(ks), (N_B, DH_B), 0.02)
    b_lam_q1 = _normal(next(ks), (N_B, DH_B), 0.1)
    b_lam_k1 = _normal(next(ks), (N_B, DH_B), 0.1)
    b_lam_q2 = _normal(next(ks), (N_B, DH_B), 0.1)
    b_lam_k2 = _normal(next(ks), (N_B, DH_B), 0.1)
    b_subln = 1.0 + _normal(next(ks), (N_B, 2 * DH_B), 0.02)
    b_w_out = _normal(next(ks), (N_B, V_B, D), V_B ** -0.5)
    moe_w_router = _normal(next(ks), (DEPTH, D, N_EXPERTS), D ** -0.5)
    moe_b_router = _normal(next(ks), (DEPTH, N_EXPERTS), 0.01)
    moe_w_gate = _normal(next(ks), (DEPTH, N_EXPERTS, D, D_EXPERT), D ** -0.5)
    moe_b_gate = _normal(next(ks), (DEPTH, N_EXPERTS, D_EXPERT), 0.02)
    moe_w_up = _normal(next(ks), (DEPTH, N_EXPERTS, D, D_EXPERT), D ** -0.5)
    moe_b_up = _normal(next(ks), (DEPTH, N_EXPERTS, D_EXPERT), 0.02)
    moe_w_down = _normal(next(ks), (DEPTH, N_EXPERTS, D_EXPERT, D), D_EXPERT ** -0.5)
    moe_b_down = _normal(next(ks), (DEPTH, N_EXPERTS, D), 0.02)
    return {"x": x, "c": c, "ada_w": ada_w, "ada_b": ada_b,
            "a_w_in": a_w_in, "a_conv": a_conv, "a_log": a_log, "a_dt_bias": a_dt_bias,
            "a_norm": a_norm, "a_w_out": a_w_out,
            "kv_ada_w": kv_ada_w, "kv_ada_b": kv_ada_b, "b_w_k": b_w_k, "b_w_v": b_w_v,
            "b_k_norm": b_k_norm, "b_w_q": b_w_q, "b_q_norm": b_q_norm,
            "b_lam_q1": b_lam_q1, "b_lam_k1": b_lam_k1, "b_lam_q2": b_lam_q2, "b_lam_k2": b_lam_k2,
            "b_subln": b_subln, "b_w_out": b_w_out,
            "moe_w_router": moe_w_router, "moe_b_router": moe_b_router,
            "moe_w_gate": moe_w_gate, "moe_b_gate": moe_b_gate,
            "moe_w_up": moe_w_up, "moe_b_up": moe_b_up,
            "moe_w_down": moe_w_down, "moe_b_down": moe_b_down}


def reference(x, c, ada_w, ada_b, a_w_in, a_conv, a_log, a_dt_bias, a_norm, a_w_out,
              kv_ada_w, kv_ada_b, b_w_k, b_w_v, b_k_norm, b_w_q, b_q_norm,
              b_lam_q1, b_lam_k1, b_lam_q2, b_lam_k2, b_subln, b_w_out,
              moe_w_router, moe_b_router, moe_w_gate, moe_b_gate, moe_w_up, moe_b_up,
              moe_w_down, moe_b_down):
    h = x
    c_act = jax.nn.silu(c)
    k_sh = None
    v_sh = None
    for l in range(DEPTH):
        mod = c_act @ ada_w[l] + ada_b[l]
        sh1, sc1, g1, sh2, sc2, g2 = jnp.split(mod, 6, axis=-1)
        xn = modulate(h, sh1, sc1)
        if l < N_A:
            y = gated_deltanet(xn, a_w_in[l], a_conv[l], a_log[l], a_dt_bias[l], a_norm[l], a_w_out[l])
        else:
            j = l - N_A
            lambda_init = 0.8 - 0.6 * math.exp(-0.3 * l)
            y = diff_attention(xn, k_sh, v_sh, b_w_q[j], b_q_norm[j], b_lam_q1[j], b_lam_k1[j],
                               b_lam_q2[j], b_lam_k2[j], b_subln[j], b_w_out[j], lambda_init)
        h = h + g1[:, None, :] * y
        xn = modulate(h, sh2, sc2)
        h = h + g2[:, None, :] * moe_ffn(xn, moe_w_router[l], moe_b_router[l], moe_w_gate[l],
                                           moe_b_gate[l], moe_w_up[l], moe_b_up[l],
                                           moe_w_down[l], moe_b_down[l])
        if l == N_A - 1:
            k_sh, v_sh = shared_kv(h, c_act, kv_ada_w, kv_ada_b, b_w_k, b_w_v, b_k_norm)
    return h
```

```cpp
#include <hip/hip_runtime.h>
#include <cstdio>

#ifndef MK_PER_PHASE
#define MK_PER_PHASE 0
#endif

#define DI __device__ __forceinline__
#define GAS __attribute__((address_space(1)))
#define LAS __attribute__((address_space(3)))
typedef unsigned short bf16;
typedef unsigned v4u __attribute__((ext_vector_type(4)));
typedef unsigned v2u __attribute__((ext_vector_type(2)));
typedef float f32x4 __attribute__((ext_vector_type(4)));
typedef float f32x2 __attribute__((ext_vector_type(2)));
typedef short bf16x8 __attribute__((ext_vector_type(8)));

constexpr int NB = 8, SEQ = 2048, D = 1024, NTOK = NB * SEQ;
constexpr int NEXP = 32;
constexpr int AIN = 4112;
constexpr float EPS = 1e-6f;
constexpr int MODW = 14336;
constexpr float LAMBDA_INIT = 0.35550906f;
constexpr int NPHASE = 18;

constexpr size_t MiB = 1u << 20;
constexpr size_t WS_CTL = 0, CTL_ZERO_BYTES = 1 * MiB;
constexpr size_t WS_MODV = 1 * MiB;
constexpr size_t WS_BETA = 2 * MiB;
constexpr size_t WS_GDEC = 2 * MiB + 512 * 1024;
constexpr size_t WS_SEL = 3 * MiB;
constexpr size_t WS_POS = 3 * MiB + 256 * 1024;
constexpr size_t WS_GATE = 3 * MiB + 512 * 1024;
constexpr size_t WS_LIST = 4 * MiB;
constexpr size_t WS_WIN = 8 * MiB;
constexpr size_t WS_WOA = 16 * MiB, WS_WKV = 18 * MiB, WS_WQ = 22 * MiB, WS_WOB = 24 * MiB;
constexpr size_t WS_WGU = 32 * MiB;
constexpr size_t WS_WD = 288 * MiB;
constexpr size_t WS_XN = 416 * MiB, WS_XKV = 448 * MiB;
constexpr size_t WS_PROJ = 480 * MiB;
constexpr size_t WS_HID = 480 * MiB;
constexpr size_t WS_Y = 624 * MiB;
constexpr size_t WS_OD = 768 * MiB, WS_KSH = 768 * MiB;
constexpr size_t WS_ON = 800 * MiB, WS_QB = 832 * MiB, WS_VSH = 864 * MiB;
constexpr size_t WS_END = 896 * MiB;
constexpr int CW_TMO = 0, CW_CODE = 1, CW_BAR = 4096, CW_CNT = 8192;

constexpr int RING_BYTES = 131072;
constexpr int LDSCTL_OFF = 139264, MISC_OFF = LDSCTL_OFF + 320, TAB_OFF = LDSCTL_OFF + 1024;
constexpr int LDS_BYTES = 163840;

#define RLX_AGENT __ATOMIC_RELAXED, __HIP_MEMORY_SCOPE_AGENT
DI unsigned f2bf(float f) { unsigned u = __builtin_bit_cast(unsigned, f); return (u + 0x7fffu + ((u >> 16) & 1u)) >> 16; }
DI unsigned pk2(float lo, float hi) { return f2bf(lo) | (f2bf(hi) << 16); }
DI float bf2f(unsigned h) { return __builtin_bit_cast(float, h << 16); }
DI float bflo(unsigned w) { return __builtin_bit_cast(float, w << 16); }
DI float bfhi(unsigned w) { return __builtin_bit_cast(float, w & 0xffff0000u); }
DI float silu_f(float x) { return x / (1.f + __expf(-x)); }
DI float sigmoid_f(float x) { return 1.f / (1.f + __expf(-x)); }
DI float softplus_f(float x) { return x > 20.f ? x : log1pf(__expf(x)); }
DI int fresh_tid() { int t = threadIdx.x; asm volatile("" : "+v"(t)); return t; }
DI float wave_sum(float v) {
#pragma unroll
    for (int o = 1; o < 64; o <<= 1) v += __shfl_xor(v, o);
    return v;
}
template <int OFF> DI void rs_step(float (&v)[64], int lane) {
    const bool up = (lane & OFF) != 0;
#pragma unroll
    for (int i = 0; i < OFF; ++i) { const float keep = up ? v[i + OFF] : v[i]; const float send = up ? v[i] : v[i + OFF]; v[i] = keep + __shfl_xor(send, OFF); }
}
DI float rs64(float (&v)[64], int lane) {
    rs_step<32>(v, lane); rs_step<16>(v, lane); rs_step<8>(v, lane); rs_step<4>(v, lane); rs_step<2>(v, lane); rs_step<1>(v, lane);
    return v[0];
}

#define XB_TMO      128
#define XB_XCNT(j)  (256  + 64 * (j))
#define XB_XSUB(j)  (1280 + 64 * (j))
#define XB_XGEN(j)  (2304 + 64 * (j))
#define XB_TOP      3328
#define XB_TOPGEN   3392
#define XCD_BAR_WORDS 3456
#define XB_SPIN_CAP (1u << 18)
DI unsigned xb_ld(unsigned* p)              { return __hip_atomic_load(p, __ATOMIC_RELAXED, __HIP_MEMORY_SCOPE_AGENT); }
DI unsigned xb_add(unsigned* p, unsigned v) { return __hip_atomic_fetch_add(p, v, __ATOMIC_RELAXED, __HIP_MEMORY_SCOPE_AGENT); }
DI unsigned xb_xcc_id() { return (unsigned)__builtin_amdgcn_s_getreg((3 << 11) | 20) & 0xFu; }
#define XB_SPIN(cond, bar) do { unsigned _sp = 0; while (cond) { __builtin_amdgcn_s_sleep(1); \
    if ((++_sp & 255u) == 0u) { if (xb_ld(&(bar)[XB_TMO])) break; if (_sp > XB_SPIN_CAP) { atomicAdd(&(bar)[XB_TMO], 1u); break; } } } } while (0)
struct XcdBarrier { unsigned* bar; unsigned x; volatile LAS unsigned* st; };
DI XcdBarrier xcd_barrier_post(unsigned* bar, volatile LAS unsigned* st) {
    XcdBarrier b; b.bar = bar; b.x = xb_xcc_id(); b.st = st;
    if (threadIdx.x == 0) (void)xb_add(&bar[XB_XCNT(b.x)], 1u);
    return b;
}
DI void xcd_barrier_complete(unsigned* bar, unsigned x, unsigned& nloc, unsigned& nx) {
    const unsigned G = gridDim.x * gridDim.y * gridDim.z;
    unsigned sum, cnt, mine, sp = 0u;
    for (;;) {
        sum = 0u; cnt = 0u; mine = 0u;
#pragma unroll
        for (unsigned j = 0; j < 16; ++j) { const unsigned c = xb_ld(&bar[XB_XCNT(j)]); sum += c; cnt += (c > 0u) ? 1u : 0u; mine = (j == x) ? c : mine; }
        if (sum == G) break;
        __builtin_amdgcn_s_sleep(1);
        if ((++sp & 255u) == 0u) { if (xb_ld(&bar[XB_TMO])) break; if (sp > XB_SPIN_CAP) { atomicAdd(&bar[XB_TMO], 1u); break; } }
    }
    nloc = mine > 0u ? mine : 1u; nx = cnt > 0u ? cnt : 1u;
}
DI void xcd_barrier(const XcdBarrier& b) {
    asm volatile("s_waitcnt vmcnt(0)" ::: "memory");
    __syncthreads();
    if (threadIdx.x == 0) {
        unsigned* bar = b.bar;
        __builtin_amdgcn_s_waitcnt(0);
        unsigned nloc = b.st[0], nx = b.st[1];
        if (nloc == 0u) { xcd_barrier_complete(bar, b.x, nloc, nx); b.st[0] = nloc; b.st[1] = nx; }
        const unsigned old = xb_add(&bar[XB_XSUB(b.x)], 1u);
        const unsigned gen = old / nloc;
        if (old + 1u == (gen + 1u) * nloc) {
            __builtin_amdgcn_fence(__ATOMIC_RELEASE, "agent");
            asm volatile("s_waitcnt vmcnt(0)" ::: "memory");
            const unsigned og = xb_add(&bar[XB_TOP], 1u);
            const unsigned tg = og / nx;
            if (og + 1u == (tg + 1u) * nx) xb_add(&bar[XB_TOPGEN], 1u);
            else XB_SPIN(xb_ld(&bar[XB_TOPGEN]) == tg, bar);
            __builtin_amdgcn_fence(__ATOMIC_ACQUIRE, "agent");
            xb_add(&bar[XB_XGEN(b.x)], 1u);
            asm volatile("s_waitcnt vmcnt(0)" ::: "memory");
        } else {
            XB_SPIN(xb_ld(&bar[XB_XGEN(b.x)]) == gen, bar);
            __builtin_amdgcn_fence(__ATOMIC_ACQUIRE, "agent");
            asm volatile("s_waitcnt vmcnt(0)" ::: "memory");
        }
    }
    __syncthreads();
}

namespace pg8 {
constexpr int BM = 256, BK = 64, HALF = 128, HTB = HALF * BK * 2, STAGE_BYTES = 8 * HTB, NXCD = 8, WGM = 8;
constexpr int KD = 1024, NT = KD / BK;
DI int lds_byte(int r, int c) { const int st = (r >> 4) * 2 + (c >> 5), rr = r & 15, cc = c & 31, ob = rr * 64 + cc * 2; return st * 1024 + (ob ^ (((ob >> 9) & 1) << 5)); }
DI void stage_rc(int b, int& R, int& C) { const int st = b / 1024, sb = b % 1024, swz = sb ^ (((sb >> 9) & 1) << 5); R = (st >> 1) * 16 + swz / 64; C = (st & 1) * 32 + (swz % 64) / 2; }
DI int perm32(int rho) { const int n = rho >> 4, i = rho & 15; return 8 * (i >> 2) + 4 * n + (i & 3); }
struct Unit { int pm, pn, ex; };
struct StaticOrder {
    int nM, nN, nwg, G, c;
    DI void init(int M, int N, int G_, int c_) { nM = M / BM; nN = N / BM; nwg = nM * nN; G = G_; c = c_; }
    DI bool next(int i, Unit& u) const {
        const long L = (long)i * G + c; if (L >= nwg) return false;
        int wgid = (int)L; { const int q = nwg / NXCD, r = nwg % NXCD, xcd = wgid % NXCD, off = wgid / NXCD; wgid = (xcd < r ? xcd * (q + 1) : r * (q + 1) + (xcd - r) * q) + off; }
        const int nig = WGM * nN, gid = wgid / nig, fm = gid * WGM, gsz = (nM - fm) < WGM ? (nM - fm) : WGM;
        u.pm = fm + ((wgid % nig) % gsz); u.pn = (wgid % nig) / gsz; u.ex = 0; return true;
    }
};
DI unsigned cvt_pk_bf16(float lo, float hi) { unsigned r; asm volatile("v_cvt_pk_bf16_f32 %0, %1, %2" : "=v"(r) : "v"(lo), "v"(hi)); return r; }

template <class P, bool ALIGN_EPI>
DI void gemm_phase(LAS unsigned char* lds, const P& pb) {
    const int tid = fresh_tid(), wid = __builtin_amdgcn_readfirstlane(tid >> 6), lane = tid & 63, wr = wid >> 2, wc = wid & 3, fr = lane & 15, fq = lane >> 4;
    constexpr int K = KD, nt = NT;
    int Rl[2], Cl[2]; unsigned voffB[2];
#pragma unroll
    for (int i = 0; i < 2; ++i) { int R, C; stage_rc(tid * 16 + i * 8192, R, C); const int Rb = P::PERM ? ((R & ~31) + perm32(R & 31)) : R;
        Rl[i] = R; Cl[i] = C; voffB[i] = (unsigned)(Rb * K + C) * 2u; }
    const size_t kstep = (size_t)(BK * 2);
    const size_t hstep = (size_t)HALF * K * 2;
    const unsigned ldsw = (unsigned)wid * 1024u;
    const int aoff = lds_byte(wr * 64 + fr, fq * 8), boff = lds_byte(wc * 32 + fr, fq * 8);
#define PG8_SA(b, h) (((b) * 2 + (h)) * HTB)
#define PG8_SB(b, h) ((4 + (b) * 2 + (h)) * HTB)
#define PG8_STAGE(bufoff, gbase, voff) do { _Pragma("unroll") for (int _i = 0; _i < 2; ++_i) \
        __builtin_amdgcn_global_load_lds((const unsigned*)((const char*)(gbase) + (voff)[_i]), (LAS unsigned*)(lds + (bufoff) + ldsw + _i * 8192), 16, 0, 0); } while (0)
#define PG8_STAGE_A(bufoff, h, vsel, kb) do { _Pragma("unroll") for (int _i = 0; _i < 2; ++_i) \
        __builtin_amdgcn_global_load_lds((const unsigned*)(abase + (size_t)(vsel)[h][_i] + (size_t)(kb)), (LAS unsigned*)(lds + (bufoff) + ldsw + _i * 8192), 16, 0, 0); } while (0)
#define PG8_LDA(dst, b, h) do { _Pragma("unroll") for (int m = 0; m < 4; ++m) _Pragma("unroll") for (int k = 0; k < 2; ++k) dst[m][k] = *(const LAS bf16x8*)(lds + PG8_SA(b, h) + aoff + m * 2048 + k * 1024); } while (0)
#define PG8_LDB(dst, b, h) do { _Pragma("unroll") for (int n = 0; n < 2; ++n) _Pragma("unroll") for (int k = 0; k < 2; ++k) dst[n][k] = *(const LAS bf16x8*)(lds + PG8_SB(b, h) + boff + n * 2048 + k * 1024); } while (0)
#define PG8_MMA(ai, bj, At, Bt) do { __builtin_amdgcn_s_setprio(1); _Pragma("unroll") for (int m = 0; m < 4; ++m) _Pragma("unroll") for (int n = 0; n < 2; ++n) _Pragma("unroll") for (int k = 0; k < 2; ++k) \
        acc[ai][bj][m][n] = __builtin_amdgcn_mfma_f32_16x16x32_bf16(Bt[n][k], At[m][k], acc[ai][bj][m][n], 0, 0, 0); __builtin_amdgcn_s_setprio(0); } while (0)
#define PG8_WAIT_V(n) asm volatile("s_waitcnt vmcnt(" #n ")" ::: "memory")
#define PG8_WAIT_L(n) asm volatile("s_waitcnt lgkmcnt(" #n ")" ::: "memory")
#define PG8_BAR __builtin_amdgcn_s_barrier()
#define PG8_SCHED __builtin_amdgcn_sched_barrier(0)
    Unit cur, nxt; int ui = 0;
    if (!pb.next(0, cur)) return;
    f32x4 acc[2][2][4][2];
#pragma unroll
    for (int a = 0; a < 2; ++a)
#pragma unroll
        for (int b = 0; b < 2; ++b)
#pragma unroll
            for (int m = 0; m < 4; ++m)
#pragma unroll
                for (int n = 0; n < 2; ++n) acc[a][b][m][n] = (f32x4){0.f, 0.f, 0.f, 0.f};
    bf16x8 At[4][2], B0[2][2], B1[2][2];
    const char* abase = pb.abase();
    unsigned vAc[2][2], vAn[2][2];
#pragma unroll
    for (int h = 0; h < 2; ++h)
#pragma unroll
        for (int i = 0; i < 2; ++i) { vAc[h][i] = pb.arow(cur, h * HALF + Rl[i]) + (unsigned)Cl[i] * 2u; vAn[h][i] = vAc[h][i]; }
    const char* cB = pb.bbase(cur);
    PG8_STAGE(PG8_SB(0, 0), cB, voffB); PG8_STAGE(PG8_SB(0, 1), cB + hstep, voffB); PG8_STAGE_A(PG8_SA(0, 0), 0, vAc, 0); PG8_STAGE_A(PG8_SA(0, 1), 1, vAc, 0);
    if (wr == 1) PG8_BAR;
    PG8_WAIT_V(2); PG8_BAR;
    PG8_STAGE(PG8_SB(1, 0), cB + kstep, voffB); PG8_STAGE_A(PG8_SA(1, 0), 0, vAc, kstep); PG8_STAGE(PG8_SB(1, 1), cB + hstep + kstep, voffB);
    PG8_WAIT_V(6); PG8_BAR;
    for (;;) {
        const bool has_next = pb.next(ui + 1, nxt);
        if (has_next) {
#pragma unroll
            for (int h = 0; h < 2; ++h)
#pragma unroll
                for (int i = 0; i < 2; ++i) vAn[h][i] = pb.arow(nxt, h * HALF + Rl[i]) + (unsigned)Cl[i] * 2u;
        } else {
#pragma unroll
            for (int h = 0; h < 2; ++h)
#pragma unroll
                for (int i = 0; i < 2; ++i) vAn[h][i] = vAc[h][i];
        }
        const char* nB = has_next ? pb.bbase(nxt) : cB;
        for (int t = 0; t < nt; t += 2) {
            const bool last = (t == nt - 2);
            const unsigned k1 = (unsigned)(t + 1) * (unsigned)kstep;
            const unsigned k2 = last ? 0u : (unsigned)(t + 2) * (unsigned)kstep;
            unsigned v2[2][2];
#pragma unroll
            for (int h = 0; h < 2; ++h)
#pragma unroll
                for (int i = 0; i < 2; ++i) v2[h][i] = last ? vAn[h][i] : vAc[h][i];
            const char* b2 = last ? nB : cB + (size_t)(t + 2) * kstep;
            const char* b3 = b2 + kstep;
            PG8_LDB(B0, 0, 0); PG8_LDB(B1, 0, 1); PG8_SCHED; PG8_LDA(At, 0, 0); PG8_STAGE_A(PG8_SA(1, 1), 1, vAc, k1);
            PG8_WAIT_V(8); PG8_WAIT_L(0); PG8_BAR; PG8_MMA(0, 0, At, B0); PG8_MMA(0, 1, At, B1); PG8_BAR; PG8_SCHED;
            PG8_LDA(At, 0, 1); PG8_STAGE(PG8_SB(0, 0), b2, voffB); PG8_STAGE(PG8_SB(0, 1), b2 + hstep, voffB); PG8_STAGE_A(PG8_SA(0, 0), 0, v2, k2);
            PG8_WAIT_V(8); PG8_WAIT_L(0); PG8_BAR; PG8_MMA(1, 0, At, B0); PG8_MMA(1, 1, At, B1); PG8_BAR; PG8_SCHED;
            PG8_LDB(B0, 1, 0); PG8_LDB(B1, 1, 1); PG8_SCHED; PG8_LDA(At, 1, 0); PG8_STAGE_A(PG8_SA(0, 1), 1, v2, k2);
            PG8_WAIT_V(8); PG8_WAIT_L(0); PG8_BAR; PG8_MMA(0, 0, At, B0); PG8_MMA(0, 1, At, B1); PG8_BAR; PG8_SCHED;
            PG8_LDA(At, 1, 1); PG8_STAGE(PG8_SB(1, 0), b3, voffB); PG8_STAGE(PG8_SB(1, 1), b3 + hstep, voffB); PG8_STAGE_A(PG8_SA(1, 0), 0, v2, k2 + (unsigned)kstep);
            PG8_WAIT_V(8); PG8_WAIT_L(0); PG8_BAR; PG8_MMA(1, 0, At, B0); PG8_MMA(1, 1, At, B1); PG8_BAR; PG8_SCHED;
        }
        if constexpr (ALIGN_EPI) { if (wr == 0) PG8_BAR; }
        pb.epi(acc, cur, wr, wc, fr, fq);
        if (!has_next) break;
#pragma unroll
        for (int a = 0; a < 2; ++a)
#pragma unroll
            for (int b = 0; b < 2; ++b)
#pragma unroll
                for (int m = 0; m < 4; ++m)
#pragma unroll
                    for (int n = 0; n < 2; ++n) acc[a][b][m][n] = (f32x4){0.f, 0.f, 0.f, 0.f};
        cur = nxt; cB = nB; ++ui;
#pragma unroll
        for (int h = 0; h < 2; ++h)
#pragma unroll
            for (int i = 0; i < 2; ++i) vAc[h][i] = vAn[h][i];
        if constexpr (ALIGN_EPI) { if (wr == 1) PG8_BAR; }
    }
    PG8_WAIT_V(0);
    if constexpr (!ALIGN_EPI) { if (wr == 0) PG8_BAR; }
    PG8_BAR;
#undef PG8_SA
#undef PG8_SB
#undef PG8_STAGE
#undef PG8_STAGE_A
#undef PG8_LDA
#undef PG8_LDB
#undef PG8_MMA
#undef PG8_WAIT_V
#undef PG8_WAIT_L
#undef PG8_BAR
#undef PG8_SCHED
}
}

struct Args { const float* in[31]; float* out; unsigned char* ws; int ph_lo, ph_hi; };
typedef const __attribute__((address_space(4))) Args* KA;
DI KA launder_args() { KA p = (KA)__builtin_amdgcn_kernarg_segment_ptr(); asm volatile("" : "+s"(p)); return p; }
enum { I_X = 0, I_C, I_ADAW, I_ADAB, I_AWIN, I_ACONV, I_ALOG, I_ADT, I_ANORM, I_AWOUT, I_KVADAW, I_KVADAB, I_BWK, I_BWV, I_BKNORM, I_BWQ, I_BQNORM,
       I_LQ1, I_LK1, I_LQ2, I_LK2, I_SUBLN, I_BWOUT, I_WR, I_BR, I_WG, I_BG, I_WU, I_BU, I_WDN, I_BDN };

using pg8::Unit;
typedef f32x4 AccT[2][2][4][2];

struct PInProj {
    static constexpr bool PERM = true;
    const char* A; const char* B; bf16* O; pg8::StaticOrder S;
    DI bool next(int i, Unit& u) const { return S.next(i, u); }
    DI const char* abase() const { return A; }
    DI unsigned arow(const Unit& u, int R) const { return (unsigned)(u.pm * 256 + R) * 2048u; }
    DI const char* bbase(const Unit& u) const { return B + (size_t)u.pn * (256 * 2048); }
    DI void epi(const AccT& acc, const Unit& u, int wr, int wc, int fr, int fq) const {
        const int row0 = u.pm * 256 + wr * 64 + fr, col0 = u.pn * 256 + wc * 32 + 8 * fq;
#pragma unroll
        for (int ai = 0; ai < 2; ++ai)
#pragma unroll
            for (int m = 0; m < 4; ++m) { bf16* rowp = O + (size_t)(row0 + ai * 128 + m * 16) * 4096 + col0;
#pragma unroll
                for (int bj = 0; bj < 2; ++bj) { const f32x4 v0 = acc[ai][bj][m][0], v1 = acc[ai][bj][m][1];
                    v4u w; w.x = pg8::cvt_pk_bf16(v0[0], v0[1]); w.y = pg8::cvt_pk_bf16(v0[2], v0[3]); w.z = pg8::cvt_pk_bf16(v1[0], v1[1]); w.w = pg8::cvt_pk_bf16(v1[2], v1[3]);
                    *(v4u*)(rowp + bj * 128) = w; } }
    }
};
struct POutProj {
    static constexpr bool PERM = false;
    const char* A; const char* B; const float* base; float* out; const float* gvec  ; pg8::StaticOrder S;
    DI bool next(int i, Unit& u) const { return S.next(i, u); }
    DI const char* abase() const { return A; }
    DI unsigned arow(const Unit& u, int R) const { return (unsigned)(u.pm * 256 + R) * 2048u; }
    DI const char* bbase(const Unit& u) const { return B + (size_t)u.pn * (256 * 2048); }
    DI void epi(const AccT& acc, const Unit& u, int wr, int wc, int fr, int fq) const {
        const int row0 = u.pm * 256 + wr * 64 + fr, col0 = u.pn * 256 + wc * 32 + 4 * fq;
        const float* gv = gvec + (size_t)((u.pm * 256) >> 11) * MODW + col0;
        f32x4 g[2][2];
#pragma unroll
        for (int bj = 0; bj < 2; ++bj)
#pragma unroll
            for (int n = 0; n < 2; ++n) g[bj][n] = *(const f32x4*)(gv + bj * 128 + n * 16);
#pragma unroll
        for (int ai = 0; ai < 2; ++ai)
#pragma unroll
            for (int m = 0; m < 4; ++m) { const size_t off = (size_t)(row0 + ai * 128 + m * 16) * 1024 + col0;
#pragma unroll
                for (int bj = 0; bj < 2; ++bj)
#pragma unroll
                    for (int n = 0; n < 2; ++n) { const f32x4 bs = *(const f32x4*)(base + off + bj * 128 + n * 16);
                        *(f32x4*)(out + off + bj * 128 + n * 16) = bs + g[bj][n] * acc[ai][bj][m][n]; } }
    }
};
struct MoeTab { const LAS int* cb; const LAS int* cnt; int total_rb; };
struct PMoe1 {
    static constexpr bool PERM = true;
    const char* A; const char* B  ; bf16* HID; const int* list; const float* bg; const float* bu; MoeTab T; int G, vcu;
    DI bool next(int i, Unit& u) const {
        const int idx = i * G + vcu; if (idx >= T.total_rb * 8) return false;
        const int pr = idx >> 3; int e = 0; while (T.cb[e + 1] <= pr) ++e;
        u.pm = pr; u.pn = idx & 7; u.ex = e; return true;
    }
    DI const char* abase() const { return A; }
    DI unsigned arow(const Unit& u, int R) const { const int pos = (u.pm - T.cb[u.ex]) * 256 + R; const int tok = pos < T.cnt[u.ex] ? list[u.ex * NTOK + pos] : 0; return (unsigned)tok * 2048u; }
    DI const char* bbase(const Unit& u) const { return B + ((size_t)u.ex * 2048 + (size_t)u.pn * 256) * 2048; }
    DI void epi(const AccT& acc, const Unit& u, int wr, int wc, int fr, int fq) const {
        const int row0 = u.pm * 256 + wr * 64 + fr, hc0 = u.pn * 128 + wc * 32 + 8 * fq;
        const float* pbg = bg + u.ex * 1024 + hc0; const float* pbu = bu + u.ex * 1024 + hc0;
        f32x4 vg[2], vu[2];
#pragma unroll
        for (int n = 0; n < 2; ++n) { vg[n] = *(const f32x4*)(pbg + 4 * n); vu[n] = *(const f32x4*)(pbu + 4 * n); }
#pragma unroll
        for (int ai = 0; ai < 2; ++ai)
#pragma unroll
            for (int m = 0; m < 4; ++m) { bf16* rowp = HID + (size_t)(row0 + ai * 128 + m * 16) * 1024 + hc0; float r[8];
#pragma unroll
                for (int n = 0; n < 2; ++n)
#pragma unroll
                    for (int j = 0; j < 4; ++j) { float g = acc[ai][0][m][n][j] + vg[n][j], uu = acc[ai][1][m][n][j] + vu[n][j];
                        g = fminf(g, 7.0f); uu = fminf(fmaxf(uu, -7.0f), 7.0f);
                        r[4 * n + j] = g * sigmoid_f(1.702f * g) * (uu + 1.0f); }
                v4u w; w.x = pg8::cvt_pk_bf16(r[0], r[1]); w.y = pg8::cvt_pk_bf16(r[2], r[3]); w.z = pg8::cvt_pk_bf16(r[4], r[5]); w.w = pg8::cvt_pk_bf16(r[6], r[7]);
                *(v4u*)rowp = w; }
    }
};
struct PMoe2 {
    static constexpr bool PERM = true;
    const char* A  ; const char* B  ; bf16* Y; const float* bd; MoeTab T; int G, vcu;
    DI bool next(int i, Unit& u) const {
        const int idx = i * G + vcu; if (idx >= T.total_rb * 4) return false;
        const int pr = idx >> 2; int e = 0; while (T.cb[e + 1] <= pr) ++e;
        u.pm = pr; u.pn = idx & 3; u.ex = e; return true;
    }
    DI const char* abase() const { return A; }
    DI unsigned arow(const Unit& u, int R) const { return (unsigned)(u.pm * 256 + R) * 2048u; }
    DI const char* bbase(const Unit& u) const { return B + ((size_t)u.ex * 1024 + (size_t)u.pn * 256) * 2048; }
    DI void epi(const AccT& acc, const Unit& u, int wr, int wc, int fr, int fq) const {
        const int row0 = u.pm * 256 + wr * 64 + fr, col0 = u.pn * 256 + wc * 32 + 8 * fq;
        const float* pb = bd + u.ex * 1024 + col0;
        f32x4 bv[2][2];
#pragma unroll
        for (int bj = 0; bj < 2; ++bj)
#pragma unroll
            for (int n = 0; n < 2; ++n) bv[bj][n] = *(const f32x4*)(pb + bj * 128 + 4 * n);
#pragma unroll
        for (int ai = 0; ai < 2; ++ai)
#pragma unroll
            for (int m = 0; m < 4; ++m) { bf16* rowp = Y + (size_t)(row0 + ai * 128 + m * 16) * 1024 + col0;
#pragma unroll
                for (int bj = 0; bj < 2; ++bj) { const f32x4 v0 = acc[ai][bj][m][0] + bv[bj][0], v1 = acc[ai][bj][m][1] + bv[bj][1];
                    v4u w; w.x = pg8::cvt_pk_bf16(v0[0], v0[1]); w.y = pg8::cvt_pk_bf16(v0[2], v0[3]); w.z = pg8::cvt_pk_bf16(v1[0], v1[1]); w.w = pg8::cvt_pk_bf16(v1[2], v1[3]);
                    *(v4u*)(rowp + bj * 128) = w; } }
    }
};
struct PKVQ {
    static constexpr bool PERM = true;
    unsigned char* ws; const float* knorm; const float* qnorm; pg8::StaticOrder S;
    DI bool next(int i, Unit& u) const { return S.next(i, u); }
    DI const char* abase() const { return (const char*)(ws + WS_XN); }
    DI unsigned arow(const Unit& u, int R) const { return (unsigned)(u.pm * 256 + R) * 2048u + (u.pn >= 8 ? 0u : (unsigned)(WS_XKV - WS_XN)); }
    DI const char* bbase(const Unit& u) const { const size_t off = u.pn >= 8 ? WS_WQ + (size_t)(u.pn - 8) * (256 * 2048) : WS_WKV + (size_t)u.pn * (256 * 2048); return (const char*)(ws + off); }
    DI void epi(const AccT& acc, const Unit& u, int wr, int wc, int fr, int fq) const {
        const int kind = u.pn >> 2;
        bf16* dst = (bf16*)(ws + (kind == 0 ? WS_KSH : (kind == 1 ? WS_VSH : WS_QB)));
        const float* kn = knorm; const float* qn = qnorm; const float* nw = kind == 2 ? qn : kn; const float sc = kind == 2 ? 0.125f : 1.0f;
        const int row0 = u.pm * 256 + wr * 64 + fr, colb = (u.pn & 3) * 256 + wc * 64 + 8 * fq;
        f32x4 w4[2][2];
#pragma unroll
        for (int bj = 0; bj < 2; ++bj)
#pragma unroll
            for (int n = 0; n < 2; ++n) { w4[bj][n] = *(const f32x4*)(nw + 32 * bj + 8 * fq + 4 * n) * sc; }
#pragma unroll
        for (int ai = 0; ai < 2; ++ai)
#pragma unroll
            for (int m = 0; m < 4; ++m) {
                float ss = 0.f;
#pragma unroll
                for (int bj = 0; bj < 2; ++bj)
#pragma unroll
                    for (int n = 0; n < 2; ++n) { const f32x4 x = acc[ai][bj][m][n]; ss += (x[0] * x[0] + x[1] * x[1]) + (x[2] * x[2] + x[3] * x[3]); }
                ss += __shfl_xor(ss, 16); ss += __shfl_xor(ss, 32);
                const float rn = kind == 1 ? 1.0f : rsqrtf(ss * (1.0f / 64.0f) + EPS);
                bf16* rowp = dst + (size_t)(row0 + ai * 128 + m * 16) * 1024 + colb;
#pragma unroll
                for (int bj = 0; bj < 2; ++bj) { f32x4 v0 = acc[ai][bj][m][0] * rn, v1 = acc[ai][bj][m][1] * rn;
                    if (kind != 1) { v0 = v0 * w4[bj][0]; v1 = v1 * w4[bj][1]; }
                    v4u w; w.x = pg8::cvt_pk_bf16(v0[0], v0[1]); w.y = pg8::cvt_pk_bf16(v0[2], v0[3]); w.z = pg8::cvt_pk_bf16(v1[0], v1[1]); w.w = pg8::cvt_pk_bf16(v1[2], v1[3]);
                    *(v4u*)(rowp + bj * 32) = w; } }
    }
};

DI void p0_modvec(KA a, LAS unsigned char* lds, int tid, int lane, int wave) {
    LAS float* cact = (LAS float*)lds;
    LAS float* red = (LAS float*)(lds + 32768);
    float* MODV = (float*)(a->ws + WS_MODV);
    if ((int)blockIdx.x >= 224) return;
    const float* c = a->in[I_C];
    for (int i = tid; i < 8192; i += 512) { const int b = i >> 10, k = i & 1023; cact[k * 8 + b] = silu_f(c[i]); }
    __syncthreads();
    for (int cg = blockIdx.x; cg < 224; cg += gridDim.x) {
        const int col0 = cg * 64; const float* W; int ld, col; const float* bp;
        if (col0 < 12288) { const int l = col0 / 6144; W = a->in[I_ADAW] + (size_t)l * 1024 * 6144; ld = 6144; col = col0 - l * 6144 + lane; bp = a->in[I_ADAB] + l * 6144 + col; }
        else { W = a->in[I_KVADAW]; ld = 2048; col = col0 - 12288 + lane; bp = a->in[I_KVADAB] + col; }
        float acc[8];
#pragma unroll
        for (int b = 0; b < 8; ++b) acc[b] = 0.f;
        const int k0 = wave * 128;
#pragma unroll 8
        for (int k = k0; k < k0 + 128; ++k) { const float w = W[(size_t)k * ld + col]; const f32x4 c0 = *(const LAS f32x4*)(cact + k * 8), c1 = *(const LAS f32x4*)(cact + k * 8 + 4);
            acc[0] += c0[0] * w; acc[1] += c0[1] * w; acc[2] += c0[2] * w; acc[3] += c0[3] * w; acc[4] += c1[0] * w; acc[5] += c1[1] * w; acc[6] += c1[2] * w; acc[7] += c1[3] * w; }
#pragma unroll
        for (int b = 0; b < 8; ++b) red[(wave * 8 + b) * 64 + lane] = acc[b];
        __syncthreads();
        float s = 0.f;
#pragma unroll
        for (int w = 0; w < 8; ++w) s += red[(w * 8 + wave) * 64 + lane];
        MODV[(size_t)wave * MODW + col0 + lane] = s + *bp;
        __syncthreads();
    }
}
template <int MODE> DI int drow_map(int n) {
    if (MODE == 1) { const int t = n & ~255, c = n & 255, wc = c >> 6, bj = (c >> 5) & 1, r = c & 31; return t + 128 * bj + 32 * wc + r; }
    if (MODE == 2) return (n >> 7) * 256 + (n & 127);
    if (MODE == 3) return (n >> 7) * 256 + 128 + (n & 127);
    return n;
}
template <int MODE> DI void transpose_item(const float* W, int ldw, bf16* WT, int kb, int nb, LAS float* scr, int lane) {
    const int k0 = 64 * kb, n0 = 64 * nb;
    const int lr = lane >> 4, lc = (lane & 15) * 4;
#pragma unroll 4
    for (int i = 0; i < 16; ++i) { const int kk = 4 * i + lr; const f32x4 v = *(const f32x4*)(W + (size_t)(k0 + kk) * ldw + n0 + lc);
        LAS float* s = scr + kk * 65 + lc; s[0] = v[0]; s[1] = v[1]; s[2] = v[2]; s[3] = v[3]; }
    asm volatile("s_waitcnt lgkmcnt(0)" ::: "memory");
    const int c = lane & 7;
#pragma unroll
    for (int j = 0; j < 8; ++j) { const int n = (lane >> 3) + 8 * j; const LAS float* s = scr + (8 * c) * 65 + n;
        v4u o; o.x = pk2(s[0 * 65], s[1 * 65]); o.y = pk2(s[2 * 65], s[3 * 65]); o.z = pk2(s[4 * 65], s[5 * 65]); o.w = pk2(s[6 * 65], s[7 * 65]);
        *(v4u*)(WT + (size_t)drow_map<MODE>(n0 + n) * 1024 + k0 + 8 * c) = o; }
    asm volatile("s_waitcnt lgkmcnt(0)" ::: "memory");
}
DI void p0_convert(KA a, LAS unsigned char* lds, int lane, int wave, int vcu, int G) {
    LAS float* scr = (LAS float*)(lds + wave * 16640);
    const int gw = vcu * 8 + wave, NGW = G * 8;
    unsigned char* ws = a->ws;
    constexpr int I_WIN = 16 * 64, I_SQ = 16 * 16;
    constexpr int NITEMS = I_WIN + 5 * I_SQ + 192 * I_SQ;
    for (int it = gw; it < NITEMS; it += NGW) {
        int r = it;
        if (r < I_WIN) { transpose_item<0>(a->in[I_AWIN], AIN, (bf16*)(ws + WS_WIN), r >> 6, r & 63, scr, lane); continue; }
        r -= I_WIN;
        const int mid = r >> 8, sub = r & 255, kb = sub >> 4, nb = sub & 15;
        if (mid == 0) { transpose_item<0>(a->in[I_AWOUT], 1024, (bf16*)(ws + WS_WOA), kb, nb, scr, lane); continue; }
        if (mid == 1) { transpose_item<1>(a->in[I_BWK], 1024, (bf16*)(ws + WS_WKV), kb, nb, scr, lane); continue; }
        if (mid == 2) { transpose_item<1>(a->in[I_BWV], 1024, (bf16*)(ws + WS_WKV) + (size_t)1024 * 1024, kb, nb, scr, lane); continue; }
        if (mid == 3) { transpose_item<1>(a->in[I_BWQ], 1024, (bf16*)(ws + WS_WQ), kb, nb, scr, lane); continue; }
        if (mid == 4) { transpose_item<0>(a->in[I_BWOUT], 1024, (bf16*)(ws + WS_WOB), kb, nb, scr, lane); continue; }
        const int mm = mid - 5, le = mm / 3, which = mm - le * 3;
        if (which == 0) transpose_item<2>(a->in[I_WG] + (size_t)le * 1048576, 1024, (bf16*)(ws + WS_WGU) + (size_t)le * 2097152, kb, nb, scr, lane);
        else if (which == 1) transpose_item<3>(a->in[I_WU] + (size_t)le * 1048576, 1024, (bf16*)(ws + WS_WGU) + (size_t)le * 2097152, kb, nb, scr, lane);
        else transpose_item<0>(a->in[I_WDN] + (size_t)le * 1048576, 1024, (bf16*)(ws + WS_WD) + (size_t)le * 1048576, kb, nb, scr, lane);
    }
}

DI void store_bf16_row(bf16* orow, int lane, const f32x4 (&v)[4]) {
    unsigned long long* o8 = (unsigned long long*)orow + lane;
#pragma unroll
    for (int j = 0; j < 4; ++j) o8[64 * j] = (unsigned long long)pk2(v[j][0], v[j][1]) | ((unsigned long long)pk2(v[j][2], v[j][3]) << 32);
}
DI void modulate_row(f32x4 (&v)[4], const float* shift, const float* scale, int lane) {
    float s = 0.f;
#pragma unroll
    for (int j = 0; j < 4; ++j) s += (v[j][0] * v[j][0] + v[j][1] * v[j][1]) + (v[j][2] * v[j][2] + v[j][3] * v[j][3]);
    const float rn = rsqrtf(wave_sum(s) * (1.0f / 1024.0f) + EPS);
#pragma unroll
    for (int j = 0; j < 4; ++j) { const f32x4 sh = *(const f32x4*)(shift + 4 * lane + 256 * j), sc = *(const f32x4*)(scale + 4 * lane + 256 * j); v[j] = v[j] * rn * (sc + 1.0f) + sh; }
}

DI void p1_norm1(KA a, LAS unsigned char* lds, int tid, int lane, int wave, int vcu, int G) {
    LAS float* wsm = (LAS float*)lds;
    const float* win = a->in[I_AWIN];
    for (int i = tid; i < 1024 * 16; i += 512) { const int k = i >> 4, jj = i & 15; const int l = (k >> 2) & 63, j = k >> 8, c = k & 3;
        wsm[(((j * 4 + c) * 4 + (jj >> 2)) * 64 + l) * 4 + (jj & 3)] = win[(size_t)k * AIN + 4096 + jj]; }
    __syncthreads();
    const float* MODV = (const float*)(a->ws + WS_MODV);
    bf16* XN = (bf16*)(a->ws + WS_XN);
    float* BETA = (float*)(a->ws + WS_BETA); float* GDEC = (float*)(a->ws + WS_GDEC);
    const int gw = vcu * 8 + wave, NGW = G * 8;
    for (int m0 = gw * 4; m0 < NTOK; m0 += NGW * 4) {
        const int b = m0 >> 11; const float* shift = MODV + (size_t)b * MODW; const float* scale = shift + 1024;
        float acc[64];
#pragma unroll
        for (int i = 0; i < 64; ++i) acc[i] = 0.f;
#pragma unroll
        for (int rp = 0; rp < 2; ++rp) {
            f32x4 v[2][4];
#pragma unroll
            for (int r2 = 0; r2 < 2; ++r2) { const int r = 2 * rp + r2; const f32x4* xr = (const f32x4*)(a->in[I_X] + (size_t)(m0 + r) * 1024) + lane;
#pragma unroll
                for (int j = 0; j < 4; ++j) v[r2][j] = xr[64 * j];
                modulate_row(v[r2], shift, scale, lane);
                store_bf16_row(XN + (size_t)(m0 + r) * 1024, lane, v[r2]); }
#pragma unroll
            for (int j = 0; j < 4; ++j)
#pragma unroll
                for (int c = 0; c < 4; ++c) {
#pragma unroll
                    for (int q = 0; q < 4; ++q) { const f32x4 w = *(const LAS f32x4*)(wsm + (((j * 4 + c) * 4 + q) * 64 + lane) * 4);
#pragma unroll
                        for (int r2 = 0; r2 < 2; ++r2) { const float xv = v[r2][j][c]; const int r = 2 * rp + r2;
                            acc[r * 16 + 4 * q + 0] += xv * w[0]; acc[r * 16 + 4 * q + 1] += xv * w[1]; acc[r * 16 + 4 * q + 2] += xv * w[2]; acc[r * 16 + 4 * q + 3] += xv * w[3]; } }
                    asm volatile("" ::: "memory"); __builtin_amdgcn_sched_barrier(0); }
        }
        const float val = rs64(acc, lane);
        const int tok = m0 + (lane >> 4), jj = lane & 15;
        if (jj < 8) BETA[tok * 8 + jj] = sigmoid_f(val);
        else { const int h = jj - 8; GDEC[tok * 8 + h] = -__expf(a->in[I_ALOG][h]) * softplus_f(val + a->in[I_ADT][h]); }
    }
}

DI void p3_delta_naive(KA a, LAS unsigned char* lds, int tid, int lane, int wave) {
    const bf16* PROJ = (const bf16*)(a->ws + WS_PROJ);
    const float* BETA = (const float*)(a->ws + WS_BETA); const float* GDEC = (const float*)(a->ws + WS_GDEC);
    bf16* OD = (bf16*)(a->ws + WS_OD);
    LAS float* buf = (LAS float*)lds;
    LAS float* gb = (LAS float*)(lds + 4096);
    for (int unit = blockIdx.x; unit < 64; unit += gridDim.x) {
        const int b = unit >> 3, h = unit & 7;
        __syncthreads();
        for (int s = tid; s < SEQ; s += 512) { gb[2 * s] = GDEC[(size_t)(b * SEQ + s) * 8 + h]; gb[2 * s + 1] = BETA[(size_t)(b * SEQ + s) * 8 + h]; }
        float S[64];
#pragma unroll
        for (int d = 0; d < 64; ++d) S[d] = 0.f;
        const int which = tid >> 7, c = tid & 127, col = (which < 3 ? which : 0) * 1024 + h * 128 + c;
        const float cw0 = a->in[I_ACONV][col], cw1 = a->in[I_ACONV][3072 + col], cw2 = a->in[I_ACONV][2 * 3072 + col], cw3 = a->in[I_ACONV][3 * 3072 + col];
        float p0 = 0.f, p1 = 0.f, p2 = 0.f;
        const bf16* pc = PROJ + (size_t)b * SEQ * 4096 + col;
        float pn = bf2f(pc[0]);
        const int se = wave * 32 + (lane & 31), dh = (lane >> 5) * 64;
        for (int s = 0; s < SEQ; ++s) {
            LAS float* cur = buf + (s & 1) * 512;
            const float pnow = pn;
            if (s + 1 < SEQ) pn = bf2f(pc[(size_t)(s + 1) * 4096]);
            const float val = silu_f(cw0 * p0 + cw1 * p1 + cw2 * p2 + cw3 * pnow); p0 = p1; p1 = p2; p2 = pnow;
            const float ss = wave_sum(val * val);
            if (tid < 384) cur[tid] = val;
            if (wave < 4 && lane == 0) cur[384 + wave] = ss;
            __syncthreads();
            if (wave < 4) {
                const float ssq = cur[384] + cur[385], ssk = cur[386] + cur[387];
                const float qsc = rsqrtf(ssq + EPS) * 0.08838834764831845f, ksc = rsqrtf(ssk + EPS);
                const float al = __expf(gb[2 * s]), bt = gb[2 * s + 1];
                float kv = 0.f;
#pragma unroll
                for (int d = 0; d < 64; d += 4) { const f32x4 kk = *(const LAS f32x4*)(cur + 128 + dh + d);
                    S[d] *= al; S[d + 1] *= al; S[d + 2] *= al; S[d + 3] *= al;
                    kv += S[d] * kk[0] + S[d + 1] * kk[1] + S[d + 2] * kk[2] + S[d + 3] * kk[3]; }
                kv += __shfl_xor(kv, 32);
                const float coef = ksc * bt * (cur[256 + se] - ksc * kv);
                float o = 0.f;
#pragma unroll
                for (int d = 0; d < 64; d += 4) { const f32x4 kk = *(const LAS f32x4*)(cur + 128 + dh + d), qq = *(const LAS f32x4*)(cur + dh + d);
                    S[d] += kk[0] * coef; S[d + 1] += kk[1] * coef; S[d + 2] += kk[2] * coef; S[d + 3] += kk[3] * coef;
                    o += S[d] * qq[0] + S[d + 1] * qq[1] + S[d + 2] * qq[2] + S[d + 3] * qq[3]; }
                o += __shfl_xor(o, 32);
                if (lane < 32) OD[(size_t)(b * SEQ + s) * 1024 + h * 128 + se] = (bf16)f2bf(o * qsc);
            }
        }
    }
}

DI void p5_gated_norm(KA a, int lane, int wave, int vcu, int G) {
    const bf16* OD = (const bf16*)(a->ws + WS_OD); const bf16* PROJ = (const bf16*)(a->ws + WS_PROJ); bf16* ON = (bf16*)(a->ws + WS_ON);
    const int gw = vcu * 8 + wave, NGW = G * 8;
    float nw[16];
#pragma unroll
    for (int i = 0; i < 16; ++i) nw[i] = a->in[I_ANORM][(16 * lane + i) & 127];
    for (int m = gw; m < NTOK; m += NGW) {
        const v4u o0 = *(const v4u*)(OD + (size_t)m * 1024 + 16 * lane), o1 = *(const v4u*)(OD + (size_t)m * 1024 + 16 * lane + 8);
        const v4u z0 = *(const v4u*)(PROJ + (size_t)m * 4096 + 3072 + 16 * lane), z1 = *(const v4u*)(PROJ + (size_t)m * 4096 + 3072 + 16 * lane + 8);
        float o[16], z[16];
#pragma unroll
        for (int i = 0; i < 4; ++i) { o[2 * i] = bflo(o0[i]); o[2 * i + 1] = bfhi(o0[i]); o[8 + 2 * i] = bflo(o1[i]); o[8 + 2 * i + 1] = bfhi(o1[i]);
            z[2 * i] = bflo(z0[i]); z[2 * i + 1] = bfhi(z0[i]); z[8 + 2 * i] = bflo(z1[i]); z[8 + 2 * i + 1] = bfhi(z1[i]); }
        float ss = 0.f;
#pragma unroll
        for (int i = 0; i < 16; ++i) ss += o[i] * o[i];
        ss += __shfl_xor(ss, 1); ss += __shfl_xor(ss, 2); ss += __shfl_xor(ss, 4);
        const float rn = rsqrtf(ss * (1.0f / 128.0f) + EPS);
        float r[16];
#pragma unroll
        for (int i = 0; i < 16; ++i) r[i] = o[i] * rn * nw[i] * silu_f(z[i]);
        v4u w0, w1;
#pragma unroll
        for (int i = 0; i < 4; ++i) { w0[i] = pk2(r[2 * i], r[2 * i + 1]); w1[i] = pk2(r[8 + 2 * i], r[8 + 2 * i + 1]); }
        *(v4u*)(ON + (size_t)m * 1024 + 16 * lane) = w0; *(v4u*)(ON + (size_t)m * 1024 + 16 * lane + 8) = w1;
    }
}

DI void p7_router(KA a, LAS unsigned char* lds, int layer, int tid, int lane, int wave, int vcu, int G) {
    LAS float* wr_l = (LAS float*)lds;
    LAS int* lcnt = (LAS int*)(lds + TAB_OFF);
    LAS int* lbase = lcnt + 32;
    LAS int* tsel = (LAS int*)(lds + TAB_OFF + 512);
    LAS float* tgate = (LAS float*)(lds + TAB_OFF + 512 + 1024);
    const float* wrt = a->in[I_WR] + (size_t)layer * 1024 * 32;
    for (int i = tid; i < 1024 * 32; i += 512) { const int k = i >> 5, e = i & 31; const int l = (k >> 2) & 63, j = k >> 8, c = k & 3;
        wr_l[(((j * 4 + c) * 8 + (e >> 2)) * 64 + l) * 4 + (e & 3)] = wrt[i]; }
    if (tid < 32) lcnt[tid] = 0;
    __syncthreads();
    const float* MODV = (const float*)(a->ws + WS_MODV);
    bf16* XN = (bf16*)(a->ws + WS_XN);
    const float* hbuf = a->out;
    int* SEL = (int*)(a->ws + WS_SEL); int* POS = (int*)(a->ws + WS_POS); float* GATE = (float*)(a->ws + WS_GATE); int* LIST = (int*)(a->ws + WS_LIST);
    unsigned* gcnt = (unsigned*)(a->ws + WS_CTL) + CW_CNT + layer * 32 * 16;
    const float bias = a->in[I_BR][layer * 32 + (lane & 31)];
    for (int grp = vcu; grp < NTOK / 64; grp += G) {
        const int t0 = grp * 64 + wave * 8;
#pragma unroll 1
        for (int pr = 0; pr < 4; ++pr) {
            const int m0 = t0 + 2 * pr; const int b = m0 >> 11;
            const float* shift = MODV + (size_t)b * MODW + layer * 6144 + 3072; const float* scale = shift + 1024;
            float acc[64];
#pragma unroll
            for (int i = 0; i < 64; ++i) acc[i] = 0.f;
#pragma unroll
            for (int r = 0; r < 2; ++r) {
                f32x4 v[4]; const f32x4* xr = (const f32x4*)(hbuf + (size_t)(m0 + r) * 1024) + lane;
#pragma unroll
                for (int j = 0; j < 4; ++j) v[j] = xr[64 * j];
                modulate_row(v, shift, scale, lane);
                store_bf16_row(XN + (size_t)(m0 + r) * 1024, lane, v);
#pragma unroll
                for (int j = 0; j < 4; ++j)
#pragma unroll
                    for (int c = 0; c < 4; ++c)
                    { _Pragma("unroll") for (int q = 0; q < 8; ++q) { const f32x4 w = *(const LAS f32x4*)(wr_l + (((j * 4 + c) * 8 + q) * 64 + lane) * 4); const float xv = v[j][c];
                            acc[r * 32 + 4 * q + 0] += xv * w[0]; acc[r * 32 + 4 * q + 1] += xv * w[1]; acc[r * 32 + 4 * q + 2] += xv * w[2]; acc[r * 32 + 4 * q + 3] += xv * w[3]; }
                      __builtin_amdgcn_sched_barrier(0); }
            }
            float val = rs64(acc, lane) + bias;
            const int e = lane & 31; const int tl = wave * 8 + 2 * pr + (lane >> 5);
            float topv[4]; int topi[4];
#pragma unroll
            for (int k = 0; k < 4; ++k) {
                float mv = val; int mi = e;
#pragma unroll
                for (int off = 16; off >= 1; off >>= 1) { const float ov = __shfl_xor(mv, off); const int oi = __shfl_xor(mi, off); if (ov > mv || (ov == mv && oi < mi)) { mv = ov; mi = oi; } }
                topv[k] = mv; topi[k] = mi; if (e == mi) val = -3.0e38f;
            }
            const float e1 = __expf(topv[1] - topv[0]), e2 = __expf(topv[2] - topv[0]), e3 = __expf(topv[3] - topv[0]);
            const float inv = 1.0f / (1.0f + e1 + e2 + e3);
            const float gk[4] = {inv, e1 * inv, e2 * inv, e3 * inv};
#pragma unroll
            for (int k = 0; k < 4; ++k) if (e == topi[k]) { const int lp = __hip_atomic_fetch_add(&lcnt[e], 1, __ATOMIC_RELAXED, __HIP_MEMORY_SCOPE_WORKGROUP); tsel[tl * 4 + k] = e | (lp << 8); tgate[tl * 4 + k] = gk[k]; }
        }
        __syncthreads();
        if (tid < 32) { const int n = lcnt[tid]; lbase[tid] = n ? (int)__hip_atomic_fetch_add(gcnt + tid * 16, (unsigned)n, RLX_AGENT) : 0; }
        __syncthreads();
        if (tid < 256) { const int tl = tid >> 2, k = tid & 3; const int se = tsel[tl * 4 + k]; const int e = se & 255, pos = lbase[e] + (se >> 8); const int tok = grp * 64 + tl;
            SEL[tok * 4 + k] = e; POS[tok * 4 + k] = pos; GATE[tok * 4 + k] = tgate[tl * 4 + k]; LIST[e * NTOK + pos] = tok; }
        __syncthreads();
        if (tid < 32) lcnt[tid] = 0;
        __syncthreads();
    }
}

DI MoeTab moe_tables(KA a, LAS unsigned char* lds, int layer, int tid) {
    LAS int* cb = (LAS int*)(lds + TAB_OFF); LAS int* cnt = cb + 64;
    unsigned* gcnt = (unsigned*)(a->ws + WS_CTL) + CW_CNT + layer * 32 * 16;
    __syncthreads();
    if (tid == 0) { int s = 0; for (int e = 0; e < 32; ++e) { const int n = (int)__hip_atomic_load(gcnt + e * 16, RLX_AGENT); cnt[e] = n; cb[e] = s; s += (n + 255) >> 8; } cb[32] = s; cb[33] = 0x7fffffff; }
    __syncthreads();
    MoeTab T; T.cb = cb; T.cnt = cnt; T.total_rb = cb[32]; return T;
}

DI void p10_combine(KA a, LAS unsigned char* lds, int layer, int tid, int lane, int wave, int vcu, int G) {
    const MoeTab T = moe_tables(a, lds, layer, tid);
    const float* MODV = (const float*)(a->ws + WS_MODV);
    const bf16* Y = (const bf16*)(a->ws + WS_Y);
    const int* SEL = (const int*)(a->ws + WS_SEL); const int* POS = (const int*)(a->ws + WS_POS); const float* GATE = (const float*)(a->ws + WS_GATE);
    bf16* XN = (bf16*)(a->ws + WS_XN); bf16* XKV = (bf16*)(a->ws + WS_XKV);
    float* hbuf = a->out;
    const int gw = vcu * 8 + wave, NGW = G * 8;
    for (int m = gw; m < NTOK; m += NGW) {
        const int b = m >> 11; const float* mod = MODV + (size_t)b * MODW;
        f32x4 v[4], s[4];
#pragma unroll
        for (int j = 0; j < 4; ++j) { v[j] = *((const f32x4*)(hbuf + (size_t)m * 1024) + lane + 64 * j); s[j] = (f32x4){0.f, 0.f, 0.f, 0.f}; }
#pragma unroll
        for (int k = 0; k < 4; ++k) {
            const int e = SEL[m * 4 + k]; const size_t slot = (size_t)T.cb[e] * 256 + POS[m * 4 + k]; const float gt = GATE[m * 4 + k];
            const v2u* yr = (const v2u*)(Y + slot * 1024) + lane;
#pragma unroll
            for (int j = 0; j < 4; ++j) { const v2u w = yr[64 * j]; s[j][0] += gt * bflo(w[0]); s[j][1] += gt * bfhi(w[0]); s[j][2] += gt * bflo(w[1]); s[j][3] += gt * bfhi(w[1]); }
        }
#pragma unroll
        for (int j = 0; j < 4; ++j) { const f32x4 g2 = *(const f32x4*)(mod + layer * 6144 + 5 * 1024 + 4 * lane + 256 * j); v[j] = v[j] + g2 * s[j];
            *((f32x4*)(hbuf + (size_t)m * 1024) + lane + 64 * j) = v[j]; }
        if (layer == 0) {
            f32x4 t[4];
#pragma unroll
            for (int j = 0; j < 4; ++j) t[j] = v[j];
            modulate_row(t, mod + 12288, mod + 12288 + 1024, lane);
            store_bf16_row(XKV + (size_t)m * 1024, lane, t);
            modulate_row(v, mod + 6144, mod + 6144 + 1024, lane);
            store_bf16_row(XN + (size_t)m * 1024, lane, v);
        }
    }
}

DI void p12_attn_naive(KA a, LAS unsigned char* lds, int tid, int lane, int wave) {
    const bf16* QB = (const bf16*)(a->ws + WS_QB); const bf16* KSH = (const bf16*)(a->ws + WS_KSH); const bf16* VSH = (const bf16*)(a->ws + WS_VSH);
    bf16* ON = (bf16*)(a->ws + WS_ON);
    LAS float* Ks = (LAS float*)lds;
    LAS float* Vs = (LAS float*)(lds + 33792);
    LAS float* Ps = (LAS float*)(lds + 33792 + 32768);
    float lam;
    { float s1 = 0.f, s2 = 0.f; for (int i = 0; i < 64; ++i) { s1 += a->in[I_LQ1][i] * a->in[I_LK1][i]; s2 += a->in[I_LQ2][i] * a->in[I_LK2][i]; } lam = __expf(s1) - __expf(s2) + LAMBDA_INIT; }
    const int r = tid >> 3, p = tid & 7;
    for (int unit = blockIdx.x; unit < 2048; unit += gridDim.x) {
        const int b = unit >> 8, h = (unit >> 5) & 7, qc = unit & 31;
        const size_t tq = (size_t)b * SEQ + qc * 64 + r;
        float q0[64], q1[64];
        { const v4u* qp = (const v4u*)(QB + tq * 1024 + h * 128);
#pragma unroll
          for (int i = 0; i < 8; ++i) { const v4u w = qp[i], w1 = qp[8 + i];
#pragma unroll
              for (int j = 0; j < 4; ++j) { q0[8 * i + 2 * j] = bflo(w[j]); q0[8 * i + 2 * j + 1] = bfhi(w[j]); q1[8 * i + 2 * j] = bflo(w1[j]); q1[8 * i + 2 * j + 1] = bfhi(w1[j]); } } }
        float O0[16], O1[16], m0 = -1e30f, m1 = -1e30f, l0 = 0.f, l1 = 0.f;
#pragma unroll
        for (int i = 0; i < 16; ++i) { O0[i] = 0.f; O1[i] = 0.f; }
        for (int kt = 0; kt <= qc; ++kt) {
            __syncthreads();
            { const int j = tid >> 3, seg = (tid & 7) * 16; const size_t tk = (size_t)b * SEQ + kt * 64 + j;
              const v4u k0 = *(const v4u*)(KSH + tk * 1024 + h * 128 + seg), k1 = *(const v4u*)(KSH + tk * 1024 + h * 128 + seg + 8);
              const v4u v0 = *(const v4u*)(VSH + tk * 1024 + h * 128 + seg), v1 = *(const v4u*)(VSH + tk * 1024 + h * 128 + seg + 8);
#pragma unroll
              for (int i = 0; i < 4; ++i) { Ks[j * 132 + seg + 2 * i] = bflo(k0[i]); Ks[j * 132 + seg + 2 * i + 1] = bfhi(k0[i]); Ks[j * 132 + seg + 8 + 2 * i] = bflo(k1[i]); Ks[j * 132 + seg + 8 + 2 * i + 1] = bfhi(k1[i]);
                  Vs[j * 128 + seg + 2 * i] = bflo(v0[i]); Vs[j * 128 + seg + 2 * i + 1] = bfhi(v0[i]); Vs[j * 128 + seg + 8 + 2 * i] = bflo(v1[i]); Vs[j * 128 + seg + 8 + 2 * i + 1] = bfhi(v1[i]); } }
            __syncthreads();
            float s0[8], s1[8];
#pragma unroll
            for (int i = 0; i < 8; ++i) { const LAS float* kr = Ks + (p + 8 * i) * 132; float x0 = 0.f, x1 = 0.f;
#pragma unroll
                for (int d = 0; d < 64; d += 4) { const f32x4 ka = *(const LAS f32x4*)(kr + d), kb = *(const LAS f32x4*)(kr + 64 + d);
                    x0 += q0[d] * ka[0] + q0[d + 1] * ka[1] + q0[d + 2] * ka[2] + q0[d + 3] * ka[3];
                    x1 += q1[d] * kb[0] + q1[d + 1] * kb[1] + q1[d + 2] * kb[2] + q1[d + 3] * kb[3]; }
                s0[i] = x0; s1[i] = x1; }
            float mx0 = s0[0], mx1 = s1[0];
#pragma unroll
            for (int i = 1; i < 8; ++i) { mx0 = fmaxf(mx0, s0[i]); mx1 = fmaxf(mx1, s1[i]); }
#pragma unroll
            for (int off = 1; off <= 4; off <<= 1) { mx0 = fmaxf(mx0, __shfl_xor(mx0, off)); mx1 = fmaxf(mx1, __shfl_xor(mx1, off)); }
            const float mn0 = fmaxf(m0, mx0), mn1 = fmaxf(m1, mx1);
            const float al0 = __expf(m0 - mn0), al1 = __expf(m1 - mn1);
            float ps0 = 0.f, ps1 = 0.f;
#pragma unroll
            for (int i = 0; i < 8; ++i) { const float e0 = __expf(s0[i] - mn0), e1 = __expf(s1[i] - mn1); ps0 += e0; ps1 += e1;
                Ps[r * 65 + p + 8 * i] = e0; Ps[64 * 65 + r * 65 + p + 8 * i] = e1; }
#pragma unroll
            for (int off = 1; off <= 4; off <<= 1) { ps0 += __shfl_xor(ps0, off); ps1 += __shfl_xor(ps1, off); }
            l0 = l0 * al0 + ps0; l1 = l1 * al1 + ps1; m0 = mn0; m1 = mn1;
#pragma unroll
            for (int i = 0; i < 16; ++i) { O0[i] *= al0; O1[i] *= al1; }
            __syncthreads();
            for (int j = 0; j < 64; ++j) { const float pa = Ps[r * 65 + j], pb2 = Ps[64 * 65 + r * 65 + j]; const LAS float* vr = Vs + j * 128 + 16 * p;
#pragma unroll
                for (int c4 = 0; c4 < 16; c4 += 4) { const f32x4 vv = *(const LAS f32x4*)(vr + c4);
                    O0[c4] += pa * vv[0]; O0[c4 + 1] += pa * vv[1]; O0[c4 + 2] += pa * vv[2]; O0[c4 + 3] += pa * vv[3];
                    O1[c4] += pb2 * vv[0]; O1[c4 + 1] += pb2 * vv[1]; O1[c4 + 2] += pb2 * vv[2]; O1[c4 + 3] += pb2 * vv[3]; } }
        }
        const float i0 = 1.0f / l0, i1 = lam / l1; float o[16], ss = 0.f;
#pragma unroll
        for (int i = 0; i < 16; ++i) { o[i] = O0[i] * i0 - O1[i] * i1; ss += o[i] * o[i]; }
        ss += __shfl_xor(ss, 1); ss += __shfl_xor(ss, 2); ss += __shfl_xor(ss, 4);
        const float rn = rsqrtf(ss * (1.0f / 128.0f) + EPS) * (1.0f - LAMBDA_INIT);
        v4u w0, w1;
#pragma unroll
        for (int i = 0; i < 4; ++i) { w0[i] = pk2(o[2 * i] * rn * a->in[I_SUBLN][16 * p + 2 * i], o[2 * i + 1] * rn * a->in[I_SUBLN][16 * p + 2 * i + 1]);
            w1[i] = pk2(o[8 + 2 * i] * rn * a->in[I_SUBLN][16 * p + 8 + 2 * i], o[8 + 2 * i + 1] * rn * a->in[I_SUBLN][16 * p + 8 + 2 * i + 1]); }
        *(v4u*)(ON + tq * 1024 + h * 128 + 16 * p) = w0; *(v4u*)(ON + tq * 1024 + h * 128 + 16 * p + 8) = w1;
    }
}

__global__ void __launch_bounds__(512, 2) fwd(Args a_by_value) {
    extern __shared__ __attribute__((aligned(16))) unsigned char lds_raw[];
    LAS unsigned char* lds = (LAS unsigned char*)lds_raw;
    const int tid = threadIdx.x;
    KA a = launder_args();
    const int G = gridDim.x; const int bx = blockIdx.x; const int vcu = (G % 8 == 0) ? (bx % 8) * (G / 8) + bx / 8 : bx;
    unsigned* ctl = (unsigned*)(a->ws + WS_CTL);
    for (int u = tid; u < (LDS_BYTES - LDSCTL_OFF) / 4; u += 512) ((LAS unsigned*)(lds + LDSCTL_OFF))[u] = 0u;
    __syncthreads();
    XcdBarrier bar; bar.bar = ctl + CW_BAR; bar.x = 0; bar.st = nullptr;
    const bool one_launch = (a->ph_hi - a->ph_lo) > 1;
    if (one_launch) bar = xcd_barrier_post(ctl + CW_BAR, (volatile LAS unsigned*)(lds + MISC_OFF) + 8);
    const int lo = a->ph_lo, hi = a->ph_hi;
#ifndef PHMASK
#define PHMASK 0xFFFFFFFFu
#endif
#define IN(k) ((((PHMASK) >> (k)) & 1u) && lo <= (k) && (k) < hi)
#define SEAM(k) do { if (IN(k) && IN((k) + 1)) xcd_barrier(bar); } while (0)
    unsigned char* ws = a->ws;

#define PH_IDS KA a = launder_args(); const int tid = fresh_tid(), lane = tid & 63, wave = __builtin_amdgcn_readfirstlane(tid >> 6); (void)tid; (void)lane; (void)wave
    if (IN(0)) { PH_IDS; p0_modvec(a, lds, tid, lane, wave); p0_convert(a, lds, lane, wave, vcu, G); }
    SEAM(0);
    if (IN(1)) { PH_IDS; p1_norm1(a, lds, tid, lane, wave, vcu, G); }
    SEAM(1);
    if (IN(2)) { PInProj P; P.A = (const char*)(ws + WS_XN); P.B = (const char*)(ws + WS_WIN); P.O = (bf16*)(ws + WS_PROJ); P.S.init(NTOK, 4096, G, bx);
        pg8::gemm_phase<PInProj, true>(lds, P); }
    SEAM(2);
    if (IN(3)) { PH_IDS; p3_delta_naive(a, lds, tid, lane, wave); }
    SEAM(3);
    SEAM(4);
    if (IN(5)) { PH_IDS; p5_gated_norm(a, lane, wave, vcu, G); }
    SEAM(5);
    if (IN(6)) { POutProj P; P.A = (const char*)(ws + WS_ON); P.B = (const char*)(ws + WS_WOA); P.base = a->in[I_X]; P.out = a->out; P.gvec = (const float*)(ws + WS_MODV) + 2 * 1024; P.S.init(NTOK, 1024, G, bx);
        pg8::gemm_phase<POutProj, false>(lds, P); }
    SEAM(6);
    if (IN(7)) { PH_IDS; p7_router(a, lds, 0, tid, lane, wave, vcu, G); }
    SEAM(7);
    if (IN(8)) { PH_IDS; PMoe1 P; P.A = (const char*)(ws + WS_XN); P.B = (const char*)(ws + WS_WGU); P.HID = (bf16*)(ws + WS_HID); P.list = (const int*)(ws + WS_LIST);
        P.bg = a->in[I_BG]; P.bu = a->in[I_BU]; P.T = moe_tables(a, lds, 0, tid); P.G = G; P.vcu = vcu;
        pg8::gemm_phase<PMoe1, true>(lds, P); }
    SEAM(8);
    if (IN(9)) { PH_IDS; PMoe2 P; P.A = (const char*)(ws + WS_HID); P.B = (const char*)(ws + WS_WD); P.Y = (bf16*)(ws + WS_Y); P.bd = a->in[I_BDN]; P.T = moe_tables(a, lds, 0, tid); P.G = G; P.vcu = vcu;
        pg8::gemm_phase<PMoe2, true>(lds, P); }
    SEAM(9);
    if (IN(10)) { PH_IDS; p10_combine(a, lds, 0, tid, lane, wave, vcu, G); }
    SEAM(10);
    if (IN(11)) { PKVQ P; P.ws = ws; P.knorm = a->in[I_BKNORM]; P.qnorm = a->in[I_BQNORM]; P.S.init(NTOK, 3072, G, bx);
        pg8::gemm_phase<PKVQ, true>(lds, P); }
    SEAM(11);
    if (IN(12)) { PH_IDS; p12_attn_naive(a, lds, tid, lane, wave); }
    SEAM(12);
    if (IN(13)) { POutProj P; P.A = (const char*)(ws + WS_ON); P.B = (const char*)(ws + WS_WOB); P.base = a->out; P.out = a->out; P.gvec = (const float*)(ws + WS_MODV) + 6144 + 2 * 1024; P.S.init(NTOK, 1024, G, bx);
        pg8::gemm_phase<POutProj, false>(lds, P); }
    SEAM(13);
    if (IN(14)) { PH_IDS; p7_router(a, lds, 1, tid, lane, wave, vcu, G); }
    SEAM(14);
    if (IN(15)) { PH_IDS; PMoe1 P; P.A = (const char*)(ws + WS_XN); P.B = (const char*)(ws + WS_WGU) + (size_t)32 * 2048 * 2048; P.HID = (bf16*)(ws + WS_HID); P.list = (const int*)(ws + WS_LIST);
        P.bg = a->in[I_BG] + 32 * 1024; P.bu = a->in[I_BU] + 32 * 1024; P.T = moe_tables(a, lds, 1, tid); P.G = G; P.vcu = vcu;
        pg8::gemm_phase<PMoe1, true>(lds, P); }
    SEAM(15);
    if (IN(16)) { PH_IDS; PMoe2 P; P.A = (const char*)(ws + WS_HID); P.B = (const char*)(ws + WS_WD) + (size_t)32 * 1024 * 2048; P.Y = (bf16*)(ws + WS_Y); P.bd = a->in[I_BDN] + 32 * 1024; P.T = moe_tables(a, lds, 1, tid); P.G = G; P.vcu = vcu;
        pg8::gemm_phase<PMoe2, true>(lds, P); }
    SEAM(16);
    if (IN(17)) { PH_IDS; p10_combine(a, lds, 1, tid, lane, wave, vcu, G); }
#undef IN
#undef SEAM
}

extern "C" void kernel_launch(void* const* d_in, const int* in_sizes, int n_in, void* d_out, int out_size, void* d_ws, size_t ws_size, hipStream_t stream) {
    static int grid = 0;
    if (grid == 0) {
        if (n_in != 31 || out_size != NTOK * D || ws_size < WS_END) { fprintf(stderr, "kernel_launch: unexpected shapes (n_in %d out %d ws %zu)\n", n_in, out_size, ws_size); grid = -1; return; }
        int dev = 0, cus = 0, per_cu = 0;
        if (hipGetDevice(&dev) != hipSuccess || hipDeviceGetAttribute(&cus, hipDeviceAttributeMultiprocessorCount, dev) != hipSuccess) { grid = -1; return; }
        if (hipFuncSetAttribute((const void*)fwd, hipFuncAttributeMaxDynamicSharedMemorySize, LDS_BYTES) != hipSuccess) { fprintf(stderr, "kernel_launch: hipFuncSetAttribute failed\n"); grid = -1; return; }
        if (hipOccupancyMaxActiveBlocksPerMultiprocessor(&per_cu, (const void*)fwd, 512, LDS_BYTES) != hipSuccess || per_cu < 1) fprintf(stderr, "kernel_launch: occupancy query says %d\n", per_cu);
        (void)hipGetLastError();
        grid = cus;
    }
    if (grid < 0) return;
    (void)hipMemsetAsync((char*)d_ws + WS_CTL, 0, CTL_ZERO_BYTES, stream);
    Args a{};
    for (int i = 0; i < 31; ++i) a.in[i] = (const float*)d_in[i];
    a.out = (float*)d_out; a.ws = (unsigned char*)d_ws;
#if MK_PER_PHASE
    for (int p = 0; p < NPHASE; ++p) {
        if (p == 4) continue;
        a.ph_lo = p; a.ph_hi = p + 1;
        hipLaunchKernelGGL(fwd, dim3(grid), dim3(512), LDS_BYTES, stream, a);
    }
#else
    a.ph_lo = 0; a.ph_hi = NPHASE;
    hipLaunchKernelGGL(fwd, dim3(grid), dim3(512), LDS_BYTES, stream, a);
#endif
}
```

```cpp
#include <hip/hip_runtime.h>
#include <cstdio>

#ifndef DELTA_NAIVE
#define DELTA_NAIVE 0
#endif
#ifndef ATTN_NAIVE
#define ATTN_NAIVE 0
#endif
#ifndef MK_PER_PHASE
#define MK_PER_PHASE 0
#endif

#define DI __device__ __forceinline__
#define GAS __attribute__((address_space(1)))
#define LAS __attribute__((address_space(3)))
typedef unsigned short bf16;
typedef unsigned v4u __attribute__((ext_vector_type(4)));
typedef unsigned v2u __attribute__((ext_vector_type(2)));
typedef float f32x4 __attribute__((ext_vector_type(4)));
typedef float f32x2 __attribute__((ext_vector_type(2)));
typedef short bf16x8 __attribute__((ext_vector_type(8)));

constexpr int NB = 8, SEQ = 2048, D = 1024, NTOK = NB * SEQ;
constexpr int NEXP = 32;
constexpr int AIN = 4112;
constexpr float EPS = 1e-6f;
constexpr int MODW = 14336;
constexpr float LAMBDA_INIT = 0.35550906f;
constexpr int NPHASE = 18;

constexpr size_t MiB = 1u << 20;
constexpr size_t WS_CTL = 0, CTL_ZERO_BYTES = 1 * MiB;
constexpr size_t WS_MODV = 1 * MiB;
constexpr size_t WS_BETA = 2 * MiB;
constexpr size_t WS_GDEC = 2 * MiB + 512 * 1024;
constexpr size_t WS_SEL = 3 * MiB;
constexpr size_t WS_POS = 3 * MiB + 256 * 1024;
constexpr size_t WS_GATE = 3 * MiB + 512 * 1024;
constexpr size_t WS_LIST = 4 * MiB;
constexpr size_t WS_WIN = 8 * MiB;
constexpr size_t WS_WOA = 16 * MiB, WS_WKV = 18 * MiB, WS_WQ = 22 * MiB, WS_WOB = 24 * MiB;
constexpr size_t WS_WGU = 32 * MiB;
constexpr size_t WS_WD = 288 * MiB;
constexpr size_t WS_XN = 416 * MiB, WS_XKV = 448 * MiB;
constexpr size_t WS_PROJ = 480 * MiB;
constexpr size_t WS_HID = 480 * MiB;
constexpr size_t WS_Y = 624 * MiB;
constexpr size_t WS_OD = 768 * MiB, WS_KSH = 768 * MiB;
constexpr size_t WS_ON = 800 * MiB, WS_QB = 832 * MiB, WS_VSH = 864 * MiB;
constexpr size_t WS_GC = 6 * MiB;
constexpr size_t WS_QN = 624 * MiB, WS_KN = 656 * MiB, WS_WW = 688 * MiB;
constexpr size_t WS_UUT = 720 * MiB;
constexpr size_t WS_QKM = 752 * MiB;
constexpr size_t WS_END = 896 * MiB;
constexpr int CW_TMO = 0, CW_CODE = 1, CW_BAR = 4096, CW_CNT = 8192;

constexpr int RING_BYTES = 131072;
constexpr int LDSCTL_OFF = 139264, MISC_OFF = LDSCTL_OFF + 320, TAB_OFF = LDSCTL_OFF + 1024;
constexpr int LDS_BYTES = 163840;

#define RLX_AGENT __ATOMIC_RELAXED, __HIP_MEMORY_SCOPE_AGENT
DI unsigned f2bf(float f) { unsigned u = __builtin_bit_cast(unsigned, f); return (u + 0x7fffu + ((u >> 16) & 1u)) >> 16; }
DI unsigned pk2(float lo, float hi) { return f2bf(lo) | (f2bf(hi) << 16); }
DI float bf2f(unsigned h) { return __builtin_bit_cast(float, h << 16); }
DI float bflo(unsigned w) { return __builtin_bit_cast(float, w << 16); }
DI float bfhi(unsigned w) { return __builtin_bit_cast(float, w & 0xffff0000u); }
DI float silu_f(float x) { return x / (1.f + __expf(-x)); }
DI float sigmoid_f(float x) { return 1.f / (1.f + __expf(-x)); }
DI float softplus_f(float x) { return x > 20.f ? x : log1pf(__expf(x)); }
DI int fresh_tid() { int t = threadIdx.x; asm volatile("" : "+v"(t)); return t; }
DI float wave_sum(float v) {
#pragma unroll
    for (int o = 1; o < 64; o <<= 1) v += __shfl_xor(v, o);
    return v;
}
template <int OFF> DI void rs_step(float (&v)[64], int lane) {
    const bool up = (lane & OFF) != 0;
#pragma unroll
    for (int i = 0; i < OFF; ++i) { const float keep = up ? v[i + OFF] : v[i]; const float send = up ? v[i] : v[i + OFF]; v[i] = keep + __shfl_xor(send, OFF); }
}
DI float rs64(float (&v)[64], int lane) {
    rs_step<32>(v, lane); rs_step<16>(v, lane); rs_step<8>(v, lane); rs_step<4>(v, lane); rs_step<2>(v, lane); rs_step<1>(v, lane);
    return v[0];
}

#define XB_TMO      128
#define XB_XCNT(j)  (256  + 64 * (j))
#define XB_XSUB(j)  (1280 + 64 * (j))
#define XB_XGEN(j)  (2304 + 64 * (j))
#define XB_TOP      3328
#define XB_TOPGEN   3392
#define XCD_BAR_WORDS 3456
#define XB_SPIN_CAP (1u << 18)
DI unsigned xb_ld(unsigned* p)              { return __hip_atomic_load(p, __ATOMIC_RELAXED, __HIP_MEMORY_SCOPE_AGENT); }
DI unsigned xb_add(unsigned* p, unsigned v) { return __hip_atomic_fetch_add(p, v, __ATOMIC_RELAXED, __HIP_MEMORY_SCOPE_AGENT); }
DI unsigned xb_xcc_id() { return (unsigned)__builtin_amdgcn_s_getreg((3 << 11) | 20) & 0xFu; }
#define XB_SPIN(cond, bar) do { unsigned _sp = 0; while (cond) { __builtin_amdgcn_s_sleep(1); \
    if ((++_sp & 255u) == 0u) { if (xb_ld(&(bar)[XB_TMO])) break; if (_sp > XB_SPIN_CAP) { atomicAdd(&(bar)[XB_TMO], 1u); break; } } } } while (0)
struct XcdBarrier { unsigned* bar; unsigned x; volatile LAS unsigned* st; };
DI XcdBarrier xcd_barrier_post(unsigned* bar, volatile LAS unsigned* st) {
    XcdBarrier b; b.bar = bar; b.x = xb_xcc_id(); b.st = st;
    if (threadIdx.x == 0) (void)xb_add(&bar[XB_XCNT(b.x)], 1u);
    return b;
}
DI void xcd_barrier_complete(unsigned* bar, unsigned x, unsigned& nloc, unsigned& nx) {
    const unsigned G = gridDim.x * gridDim.y * gridDim.z;
    unsigned sum, cnt, mine, sp = 0u;
    for (;;) {
        sum = 0u; cnt = 0u; mine = 0u;
#pragma unroll
        for (unsigned j = 0; j < 16; ++j) { const unsigned c = xb_ld(&bar[XB_XCNT(j)]); sum += c; cnt += (c > 0u) ? 1u : 0u; mine = (j == x) ? c : mine; }
        if (sum == G) break;
        __builtin_amdgcn_s_sleep(1);
        if ((++sp & 255u) == 0u) { if (xb_ld(&bar[XB_TMO])) break; if (sp > XB_SPIN_CAP) { atomicAdd(&bar[XB_TMO], 1u); break; } }
    }
    nloc = mine > 0u ? mine : 1u; nx = cnt > 0u ? cnt : 1u;
}
DI void xcd_barrier(const XcdBarrier& b) {
    asm volatile("s_waitcnt vmcnt(0)" ::: "memory");
    __syncthreads();
    if (threadIdx.x == 0) {
        unsigned* bar = b.bar;
        __builtin_amdgcn_s_waitcnt(0);
        unsigned nloc = b.st[0], nx = b.st[1];
        if (nloc == 0u) { xcd_barrier_complete(bar, b.x, nloc, nx); b.st[0] = nloc; b.st[1] = nx; }
        const unsigned old = xb_add(&bar[XB_XSUB(b.x)], 1u);
        const unsigned gen = old / nloc;
        if (old + 1u == (gen + 1u) * nloc) {
            __builtin_amdgcn_fence(__ATOMIC_RELEASE, "agent");
            asm volatile("s_waitcnt vmcnt(0)" ::: "memory");
            const unsigned og = xb_add(&bar[XB_TOP], 1u);
            const unsigned tg = og / nx;
            if (og + 1u == (tg + 1u) * nx) xb_add(&bar[XB_TOPGEN], 1u);
            else XB_SPIN(xb_ld(&bar[XB_TOPGEN]) == tg, bar);
            __builtin_amdgcn_fence(__ATOMIC_ACQUIRE, "agent");
            xb_add(&bar[XB_XGEN(b.x)], 1u);
            asm volatile("s_waitcnt vmcnt(0)" ::: "memory");
        } else {
            XB_SPIN(xb_ld(&bar[XB_XGEN(b.x)]) == gen, bar);
            __builtin_amdgcn_fence(__ATOMIC_ACQUIRE, "agent");
            asm volatile("s_waitcnt vmcnt(0)" ::: "memory");
        }
    }
    __syncthreads();
}

namespace pg8 {
constexpr int BM = 256, BK = 64, HALF = 128, HTB = HALF * BK * 2, STAGE_BYTES = 8 * HTB, NXCD = 8, WGM = 8;
constexpr int KD = 1024, NT = KD / BK;
DI int lds_byte(int r, int c) { const int st = (r >> 4) * 2 + (c >> 5), rr = r & 15, cc = c & 31, ob = rr * 64 + cc * 2; return st * 1024 + (ob ^ (((ob >> 9) & 1) << 5)); }
DI void stage_rc(int b, int& R, int& C) { const int st = b / 1024, sb = b % 1024, swz = sb ^ (((sb >> 9) & 1) << 5); R = (st >> 1) * 16 + swz / 64; C = (st & 1) * 32 + (swz % 64) / 2; }
DI int perm32(int rho) { const int n = rho >> 4, i = rho & 15; return 8 * (i >> 2) + 4 * n + (i & 3); }
struct Unit { int pm, pn, ex; };
struct StaticOrder {
    int nM, nN, nwg, G, c;
    DI void init(int M, int N, int G_, int c_) { nM = M / BM; nN = N / BM; nwg = nM * nN; G = G_; c = c_; }
    DI bool next(int i, Unit& u) const {
        const long L = (long)i * G + c; if (L >= nwg) return false;
        int wgid = (int)L; { const int q = nwg / NXCD, r = nwg % NXCD, xcd = wgid % NXCD, off = wgid / NXCD; wgid = (xcd < r ? xcd * (q + 1) : r * (q + 1) + (xcd - r) * q) + off; }
        const int nig = WGM * nN, gid = wgid / nig, fm = gid * WGM, gsz = (nM - fm) < WGM ? (nM - fm) : WGM;
        u.pm = fm + ((wgid % nig) % gsz); u.pn = (wgid % nig) / gsz; u.ex = 0; return true;
    }
};
DI unsigned cvt_pk_bf16(float lo, float hi) { unsigned r; asm volatile("v_cvt_pk_bf16_f32 %0, %1, %2" : "=v"(r) : "v"(lo), "v"(hi)); return r; }

template <class P, bool ALIGN_EPI>
DI void gemm_phase(LAS unsigned char* lds, const P& pb) {
    const int tid = fresh_tid(), wid = __builtin_amdgcn_readfirstlane(tid >> 6), lane = tid & 63, wr = wid >> 2, wc = wid & 3, fr = lane & 15, fq = lane >> 4;
    constexpr int K = KD, nt = NT;
    int Rl[2], Cl[2]; unsigned voffB[2];
#pragma unroll
    for (int i = 0; i < 2; ++i) { int R, C; stage_rc(tid * 16 + i * 8192, R, C); const int Rb = P::PERM ? ((R & ~31) + perm32(R & 31)) : R;
        Rl[i] = R; Cl[i] = C; voffB[i] = (unsigned)(Rb * K + C) * 2u; }
    const size_t kstep = (size_t)(BK * 2);
    const size_t hstep = (size_t)HALF * K * 2;
    const unsigned ldsw = (unsigned)wid * 1024u;
    const int aoff = lds_byte(wr * 64 + fr, fq * 8), boff = lds_byte(wc * 32 + fr, fq * 8);
#define PG8_SA(b, h) (((b) * 2 + (h)) * HTB)
#define PG8_SB(b, h) ((4 + (b) * 2 + (h)) * HTB)
#define PG8_STAGE(bufoff, gbase, voff) do { _Pragma("unroll") for (int _i = 0; _i < 2; ++_i) \
        __builtin_amdgcn_global_load_lds((const unsigned*)((const char*)(gbase) + (voff)[_i]), (LAS unsigned*)(lds + (bufoff) + ldsw + _i * 8192), 16, 0, 0); } while (0)
#define PG8_STAGE_A(bufoff, h, vsel, kb) do { _Pragma("unroll") for (int _i = 0; _i < 2; ++_i) \
        __builtin_amdgcn_global_load_lds((const unsigned*)(abase + (size_t)(vsel)[h][_i] + (size_t)(kb)), (LAS unsigned*)(lds + (bufoff) + ldsw + _i * 8192), 16, 0, 0); } while (0)
#define PG8_LDA(dst, b, h) do { _Pragma("unroll") for (int m = 0; m < 4; ++m) _Pragma("unroll") for (int k = 0; k < 2; ++k) dst[m][k] = *(const LAS bf16x8*)(lds + PG8_SA(b, h) + aoff + m * 2048 + k * 1024); } while (0)
#define PG8_LDB(dst, b, h) do { _Pragma("unroll") for (int n = 0; n < 2; ++n) _Pragma("unroll") for (int k = 0; k < 2; ++k) dst[n][k] = *(const LAS bf16x8*)(lds + PG8_SB(b, h) + boff + n * 2048 + k * 1024); } while (0)
#define PG8_MMA(ai, bj, At, Bt) do { __builtin_amdgcn_s_setprio(1); _Pragma("unroll") for (int m = 0; m < 4; ++m) _Pragma("unroll") for (int n = 0; n < 2; ++n) _Pragma("unroll") for (int k = 0; k < 2; ++k) \
        acc[ai][bj][m][n] = __builtin_amdgcn_mfma_f32_16x16x32_bf16(Bt[n][k], At[m][k], acc[ai][bj][m][n], 0, 0, 0); __builtin_amdgcn_s_setprio(0); } while (0)
#define PG8_WAIT_V(n) asm volatile("s_waitcnt vmcnt(" #n ")" ::: "memory")
#define PG8_WAIT_L(n) asm volatile("s_waitcnt lgkmcnt(" #n ")" ::: "memory")
#define PG8_BAR __builtin_amdgcn_s_barrier()
#define PG8_SCHED __builtin_amdgcn_sched_barrier(0)
    Unit cur, nxt; int ui = 0;
    if (!pb.next(0, cur)) return;
    f32x4 acc[2][2][4][2];
#pragma unroll
    for (int a = 0; a < 2; ++a)
#pragma unroll
        for (int b = 0; b < 2; ++b)
#pragma unroll
            for (int m = 0; m < 4; ++m)
#pragma unroll
                for (int n = 0; n < 2; ++n) acc[a][b][m][n] = (f32x4){0.f, 0.f, 0.f, 0.f};
    bf16x8 At[4][2], B0[2][2], B1[2][2];
    const char* abase = pb.abase();
    unsigned vAc[2][2], vAn[2][2];
#pragma unroll
    for (int h = 0; h < 2; ++h)
#pragma unroll
        for (int i = 0; i < 2; ++i) { vAc[h][i] = pb.arow(cur, h * HALF + Rl[i]) + (unsigned)Cl[i] * 2u; vAn[h][i] = vAc[h][i]; }
    const char* cB = pb.bbase(cur);
    PG8_STAGE(PG8_SB(0, 0), cB, voffB); PG8_STAGE(PG8_SB(0, 1), cB + hstep, voffB); PG8_STAGE_A(PG8_SA(0, 0), 0, vAc, 0); PG8_STAGE_A(PG8_SA(0, 1), 1, vAc, 0);
    if (wr == 1) PG8_BAR;
    PG8_WAIT_V(2); PG8_BAR;
    PG8_STAGE(PG8_SB(1, 0), cB + kstep, voffB); PG8_STAGE_A(PG8_SA(1, 0), 0, vAc, kstep); PG8_STAGE(PG8_SB(1, 1), cB + hstep + kstep, voffB);
    PG8_WAIT_V(6); PG8_BAR;
    for (;;) {
        const bool has_next = pb.next(ui + 1, nxt);
        if (has_next) {
#pragma unroll
            for (int h = 0; h < 2; ++h)
#pragma unroll
                for (int i = 0; i < 2; ++i) vAn[h][i] = pb.arow(nxt, h * HALF + Rl[i]) + (unsigned)Cl[i] * 2u;
        } else {
#pragma unroll
            for (int h = 0; h < 2; ++h)
#pragma unroll
                for (int i = 0; i < 2; ++i) vAn[h][i] = vAc[h][i];
        }
        const char* nB = has_next ? pb.bbase(nxt) : cB;
        for (int t = 0; t < nt; t += 2) {
            const bool last = (t == nt - 2);
            const unsigned k1 = (unsigned)(t + 1) * (unsigned)kstep;
            const unsigned k2 = last ? 0u : (unsigned)(t + 2) * (unsigned)kstep;
            unsigned v2[2][2];
#pragma unroll
            for (int h = 0; h < 2; ++h)
#pragma unroll
                for (int i = 0; i < 2; ++i) v2[h][i] = last ? vAn[h][i] : vAc[h][i];
            const char* b2 = last ? nB : cB + (size_t)(t + 2) * kstep;
            const char* b3 = b2 + kstep;
            PG8_LDB(B0, 0, 0); PG8_LDB(B1, 0, 1); PG8_SCHED; PG8_LDA(At, 0, 0); PG8_STAGE_A(PG8_SA(1, 1), 1, vAc, k1);
            PG8_WAIT_V(8); PG8_WAIT_L(0); PG8_BAR; PG8_MMA(0, 0, At, B0); PG8_MMA(0, 1, At, B1); PG8_BAR; PG8_SCHED;
            PG8_LDA(At, 0, 1); PG8_STAGE(PG8_SB(0, 0), b2, voffB); PG8_STAGE(PG8_SB(0, 1), b2 + hstep, voffB); PG8_STAGE_A(PG8_SA(0, 0), 0, v2, k2);
            PG8_WAIT_V(8); PG8_WAIT_L(0); PG8_BAR; PG8_MMA(1, 0, At, B0); PG8_MMA(1, 1, At, B1); PG8_BAR; PG8_SCHED;
            PG8_LDB(B0, 1, 0); PG8_LDB(B1, 1, 1); PG8_SCHED; PG8_LDA(At, 1, 0); PG8_STAGE_A(PG8_SA(0, 1), 1, v2, k2);
            PG8_WAIT_V(8); PG8_WAIT_L(0); PG8_BAR; PG8_MMA(0, 0, At, B0); PG8_MMA(0, 1, At, B1); PG8_BAR; PG8_SCHED;
            PG8_LDA(At, 1, 1); PG8_STAGE(PG8_SB(1, 0), b3, voffB); PG8_STAGE(PG8_SB(1, 1), b3 + hstep, voffB); PG8_STAGE_A(PG8_SA(1, 0), 0, v2, k2 + (unsigned)kstep);
            PG8_WAIT_V(8); PG8_WAIT_L(0); PG8_BAR; PG8_MMA(1, 0, At, B0); PG8_MMA(1, 1, At, B1); PG8_BAR; PG8_SCHED;
        }
        if constexpr (ALIGN_EPI) { if (wr == 0) PG8_BAR; }
        pb.epi(acc, cur, wr, wc, fr, fq);
        if (!has_next) break;
#pragma unroll
        for (int a = 0; a < 2; ++a)
#pragma unroll
            for (int b = 0; b < 2; ++b)
#pragma unroll
                for (int m = 0; m < 4; ++m)
#pragma unroll
                    for (int n = 0; n < 2; ++n) acc[a][b][m][n] = (f32x4){0.f, 0.f, 0.f, 0.f};
        cur = nxt; cB = nB; ++ui;
#pragma unroll
        for (int h = 0; h < 2; ++h)
#pragma unroll
            for (int i = 0; i < 2; ++i) vAc[h][i] = vAn[h][i];
        if constexpr (ALIGN_EPI) { if (wr == 1) PG8_BAR; }
    }
    PG8_WAIT_V(0);
    if constexpr (!ALIGN_EPI) { if (wr == 0) PG8_BAR; }
    PG8_BAR;
#undef PG8_SA
#undef PG8_SB
#undef PG8_STAGE
#undef PG8_STAGE_A
#undef PG8_LDA
#undef PG8_LDB
#undef PG8_MMA
#undef PG8_WAIT_V
#undef PG8_WAIT_L
#undef PG8_BAR
#undef PG8_SCHED
}
}

struct Args { const float* in[31]; float* out; unsigned char* ws; int ph_lo, ph_hi; };
typedef const __attribute__((address_space(4))) Args* KA;
DI KA launder_args() { KA p = (KA)__builtin_amdgcn_kernarg_segment_ptr(); asm volatile("" : "+s"(p)); return p; }
enum { I_X = 0, I_C, I_ADAW, I_ADAB, I_AWIN, I_ACONV, I_ALOG, I_ADT, I_ANORM, I_AWOUT, I_KVADAW, I_KVADAB, I_BWK, I_BWV, I_BKNORM, I_BWQ, I_BQNORM,
       I_LQ1, I_LK1, I_LQ2, I_LK2, I_SUBLN, I_BWOUT, I_WR, I_BR, I_WG, I_BG, I_WU, I_BU, I_WDN, I_BDN };

using pg8::Unit;
typedef f32x4 AccT[2][2][4][2];

struct PInProj {
    static constexpr bool PERM = true;
    const char* A; const char* B; bf16* O; pg8::StaticOrder S;
    DI bool next(int i, Unit& u) const { return S.next(i, u); }
    DI const char* abase() const { return A; }
    DI unsigned arow(const Unit& u, int R) const { return (unsigned)(u.pm * 256 + R) * 2048u; }
    DI const char* bbase(const Unit& u) const { return B + (size_t)u.pn * (256 * 2048); }
    DI void epi(const AccT& acc, const Unit& u, int wr, int wc, int fr, int fq) const {
        const int row0 = u.pm * 256 + wr * 64 + fr, col0 = u.pn * 256 + wc * 32 + 8 * fq;
#pragma unroll
        for (int ai = 0; ai < 2; ++ai)
#pragma unroll
            for (int m = 0; m < 4; ++m) { bf16* rowp = O + (size_t)(row0 + ai * 128 + m * 16) * 4096 + col0;
#pragma unroll
                for (int bj = 0; bj < 2; ++bj) { const f32x4 v0 = acc[ai][bj][m][0], v1 = acc[ai][bj][m][1];
                    v4u w; w.x = pg8::cvt_pk_bf16(v0[0], v0[1]); w.y = pg8::cvt_pk_bf16(v0[2], v0[3]); w.z = pg8::cvt_pk_bf16(v1[0], v1[1]); w.w = pg8::cvt_pk_bf16(v1[2], v1[3]);
                    *(v4u*)(rowp + bj * 128) = w; } }
    }
};
struct POutProj {
    static constexpr bool PERM = false;
    const char* A; const char* B; const float* base; float* out; const float* gvec  ; pg8::StaticOrder S;
    DI bool next(int i, Unit& u) const { return S.next(i, u); }
    DI const char* abase() const { return A; }
    DI unsigned arow(const Unit& u, int R) const { return (unsigned)(u.pm * 256 + R) * 2048u; }
    DI const char* bbase(const Unit& u) const { return B + (size_t)u.pn * (256 * 2048); }
    DI void epi(const AccT& acc, const Unit& u, int wr, int wc, int fr, int fq) const {
        const int row0 = u.pm * 256 + wr * 64 + fr, col0 = u.pn * 256 + wc * 32 + 4 * fq;
        const float* gv = gvec + (size_t)((u.pm * 256) >> 11) * MODW + col0;
        f32x4 g[2][2];
#pragma unroll
        for (int bj = 0; bj < 2; ++bj)
#pragma unroll
            for (int n = 0; n < 2; ++n) g[bj][n] = *(const f32x4*)(gv + bj * 128 + n * 16);
#pragma unroll
        for (int ai = 0; ai < 2; ++ai)
#pragma unroll
            for (int m = 0; m < 4; ++m) { const size_t off = (size_t)(row0 + ai * 128 + m * 16) * 1024 + col0;
#pragma unroll
                for (int bj = 0; bj < 2; ++bj)
#pragma unroll
                    for (int n = 0; n < 2; ++n) { const f32x4 bs = *(const f32x4*)(base + off + bj * 128 + n * 16);
                        *(f32x4*)(out + off + bj * 128 + n * 16) = bs + g[bj][n] * acc[ai][bj][m][n]; } }
    }
};
struct MoeTab { const LAS int* cb; const LAS int* cnt; int total_rb; };
struct PMoe1 {
    static constexpr bool PERM = true;
    const char* A; const char* B  ; bf16* HID; const int* list; const float* bg; const float* bu; MoeTab T; int G, vcu;
    DI bool next(int i, Unit& u) const {
        const int idx = i * G + vcu; if (idx >= T.total_rb * 8) return false;
        const int pr = idx >> 3; int e = 0; while (T.cb[e + 1] <= pr) ++e;
        u.pm = pr; u.pn = idx & 7; u.ex = e; return true;
    }
    DI const char* abase() const { return A; }
    DI unsigned arow(const Unit& u, int R) const { const int pos = (u.pm - T.cb[u.ex]) * 256 + R; const int tok = pos < T.cnt[u.ex] ? list[u.ex * NTOK + pos] : 0; return (unsigned)tok * 2048u; }
    DI const char* bbase(const Unit& u) const { return B + ((size_t)u.ex * 2048 + (size_t)u.pn * 256) * 2048; }
    DI void epi(const AccT& acc, const Unit& u, int wr, int wc, int fr, int fq) const {
        const int row0 = u.pm * 256 + wr * 64 + fr, hc0 = u.pn * 128 + wc * 32 + 8 * fq;
        const float* pbg = bg + u.ex * 1024 + hc0; const float* pbu = bu + u.ex * 1024 + hc0;
        f32x4 vg[2], vu[2];
#pragma unroll
        for (int n = 0; n < 2; ++n) { vg[n] = *(const f32x4*)(pbg + 4 * n); vu[n] = *(const f32x4*)(pbu + 4 * n); }
#pragma unroll
        for (int ai = 0; ai < 2; ++ai)
#pragma unroll
            for (int m = 0; m < 4; ++m) { bf16* rowp = HID + (size_t)(row0 + ai * 128 + m * 16) * 1024 + hc0; float r[8];
#pragma unroll
                for (int n = 0; n < 2; ++n)
#pragma unroll
                    for (int j = 0; j < 4; ++j) { float g = acc[ai][0][m][n][j] + vg[n][j], uu = acc[ai][1][m][n][j] + vu[n][j];
                        g = fminf(g, 7.0f); uu = fminf(fmaxf(uu, -7.0f), 7.0f);
                        r[4 * n + j] = g * sigmoid_f(1.702f * g) * (uu + 1.0f); }
                v4u w; w.x = pg8::cvt_pk_bf16(r[0], r[1]); w.y = pg8::cvt_pk_bf16(r[2], r[3]); w.z = pg8::cvt_pk_bf16(r[4], r[5]); w.w = pg8::cvt_pk_bf16(r[6], r[7]);
                *(v4u*)rowp = w; }
    }
};
struct PMoe2 {
    static constexpr bool PERM = true;
    const char* A  ; const char* B  ; bf16* Y; const float* bd; MoeTab T; int G, vcu;
    DI bool next(int i, Unit& u) const {
        const int idx = i * G + vcu; if (idx >= T.total_rb * 4) return false;
        const int pr = idx >> 2; int e = 0; while (T.cb[e + 1] <= pr) ++e;
        u.pm = pr; u.pn = idx & 3; u.ex = e; return true;
    }
    DI const char* abase() const { return A; }
    DI unsigned arow(const Unit& u, int R) const { return (unsigned)(u.pm * 256 + R) * 2048u; }
    DI const char* bbase(const Unit& u) const { return B + ((size_t)u.ex * 1024 + (size_t)u.pn * 256) * 2048; }
    DI void epi(const AccT& acc, const Unit& u, int wr, int wc, int fr, int fq) const {
        const int row0 = u.pm * 256 + wr * 64 + fr, col0 = u.pn * 256 + wc * 32 + 8 * fq;
        const float* pb = bd + u.ex * 1024 + col0;
        f32x4 bv[2][2];
#pragma unroll
        for (int bj = 0; bj < 2; ++bj)
#pragma unroll
            for (int n = 0; n < 2; ++n) bv[bj][n] = *(const f32x4*)(pb + bj * 128 + 4 * n);
#pragma unroll
        for (int ai = 0; ai < 2; ++ai)
#pragma unroll
            for (int m = 0; m < 4; ++m) { bf16* rowp = Y + (size_t)(row0 + ai * 128 + m * 16) * 1024 + col0;
#pragma unroll
                for (int bj = 0; bj < 2; ++bj) { const f32x4 v0 = acc[ai][bj][m][0] + bv[bj][0], v1 = acc[ai][bj][m][1] + bv[bj][1];
                    v4u w; w.x = pg8::cvt_pk_bf16(v0[0], v0[1]); w.y = pg8::cvt_pk_bf16(v0[2], v0[3]); w.z = pg8::cvt_pk_bf16(v1[0], v1[1]); w.w = pg8::cvt_pk_bf16(v1[2], v1[3]);
                    *(v4u*)(rowp + bj * 128) = w; } }
    }
};
struct PKVQ {
    static constexpr bool PERM = true;
    unsigned char* ws; const float* knorm; const float* qnorm; pg8::StaticOrder S;
    DI bool next(int i, Unit& u) const { return S.next(i, u); }
    DI const char* abase() const { return (const char*)(ws + WS_XN); }
    DI unsigned arow(const Unit& u, int R) const { return (unsigned)(u.pm * 256 + R) * 2048u + (u.pn >= 8 ? 0u : (unsigned)(WS_XKV - WS_XN)); }
    DI const char* bbase(const Unit& u) const { const size_t off = u.pn >= 8 ? WS_WQ + (size_t)(u.pn - 8) * (256 * 2048) : WS_WKV + (size_t)u.pn * (256 * 2048); return (const char*)(ws + off); }
    DI void epi(const AccT& acc, const Unit& u, int wr, int wc, int fr, int fq) const {
        const int kind = u.pn >> 2;
        bf16* dst = (bf16*)(ws + (kind == 0 ? WS_KSH : (kind == 1 ? WS_VSH : WS_QB)));
        const float* kn = knorm; const float* qn = qnorm; const float* nw = kind == 2 ? qn : kn; const float sc = kind == 2 ? 0.125f : 1.0f;
        const int row0 = u.pm * 256 + wr * 64 + fr, colb = (u.pn & 3) * 256 + wc * 64 + 8 * fq;
        f32x4 w4[2][2];
#pragma unroll
        for (int bj = 0; bj < 2; ++bj)
#pragma unroll
            for (int n = 0; n < 2; ++n) { w4[bj][n] = *(const f32x4*)(nw + 32 * bj + 8 * fq + 4 * n) * sc; }
#pragma unroll
        for (int ai = 0; ai < 2; ++ai)
#pragma unroll
            for (int m = 0; m < 4; ++m) {
                float ss = 0.f;
#pragma unroll
                for (int bj = 0; bj < 2; ++bj)
#pragma unroll
                    for (int n = 0; n < 2; ++n) { const f32x4 x = acc[ai][bj][m][n]; ss += (x[0] * x[0] + x[1] * x[1]) + (x[2] * x[2] + x[3] * x[3]); }
                ss += __shfl_xor(ss, 16); ss += __shfl_xor(ss, 32);
                const float rn = kind == 1 ? 1.0f : rsqrtf(ss * (1.0f / 64.0f) + EPS);
                bf16* rowp = dst + (size_t)(row0 + ai * 128 + m * 16) * 1024 + colb;
#pragma unroll
                for (int bj = 0; bj < 2; ++bj) { f32x4 v0 = acc[ai][bj][m][0] * rn, v1 = acc[ai][bj][m][1] * rn;
                    if (kind != 1) { v0 = v0 * w4[bj][0]; v1 = v1 * w4[bj][1]; }
                    v4u w; w.x = pg8::cvt_pk_bf16(v0[0], v0[1]); w.y = pg8::cvt_pk_bf16(v0[2], v0[3]); w.z = pg8::cvt_pk_bf16(v1[0], v1[1]); w.w = pg8::cvt_pk_bf16(v1[2], v1[3]);
                    *(v4u*)(rowp + bj * 32) = w; } }
    }
};

DI void p0_modvec(KA a, LAS unsigned char* lds, int tid, int lane, int wave) {
    LAS float* cact = (LAS float*)lds;
    LAS float* red = (LAS float*)(lds + 32768);
    float* MODV = (float*)(a->ws + WS_MODV);
    if ((int)blockIdx.x >= 224) return;
    const float* c = a->in[I_C];
    for (int i = tid; i < 8192; i += 512) { const int b = i >> 10, k = i & 1023; cact[k * 8 + b] = silu_f(c[i]); }
    __syncthreads();
    for (int cg = blockIdx.x; cg < 224; cg += gridDim.x) {
        const int col0 = cg * 64; const float* W; int ld, col; const float* bp;
        if (col0 < 12288) { const int l = col0 / 6144; W = a->in[I_ADAW] + (size_t)l * 1024 * 6144; ld = 6144; col = col0 - l * 6144 + lane; bp = a->in[I_ADAB] + l * 6144 + col; }
        else { W = a->in[I_KVADAW]; ld = 2048; col = col0 - 12288 + lane; bp = a->in[I_KVADAB] + col; }
        float acc[8];
#pragma unroll
        for (int b = 0; b < 8; ++b) acc[b] = 0.f;
        const int k0 = wave * 128;
#pragma unroll 8
        for (int k = k0; k < k0 + 128; ++k) { const float w = W[(size_t)k * ld + col]; const f32x4 c0 = *(const LAS f32x4*)(cact + k * 8), c1 = *(const LAS f32x4*)(cact + k * 8 + 4);
            acc[0] += c0[0] * w; acc[1] += c0[1] * w; acc[2] += c0[2] * w; acc[3] += c0[3] * w; acc[4] += c1[0] * w; acc[5] += c1[1] * w; acc[6] += c1[2] * w; acc[7] += c1[3] * w; }
#pragma unroll
        for (int b = 0; b < 8; ++b) red[(wave * 8 + b) * 64 + lane] = acc[b];
        __syncthreads();
        float s = 0.f;
#pragma unroll
        for (int w = 0; w < 8; ++w) s += red[(w * 8 + wave) * 64 + lane];
        MODV[(size_t)wave * MODW + col0 + lane] = s + *bp;
        __syncthreads();
    }
}
template <int MODE> DI int drow_map(int n) {
    if (MODE == 1) { const int t = n & ~255, c = n & 255, wc = c >> 6, bj = (c >> 5) & 1, r = c & 31; return t + 128 * bj + 32 * wc + r; }
    if (MODE == 2) return (n >> 7) * 256 + (n & 127);
    if (MODE == 3) return (n >> 7) * 256 + 128 + (n & 127);
    return n;
}
template <int MODE> DI void transpose_item(const float* W, int ldw, bf16* WT, int kb, int nb, LAS float* scr, int lane) {
    const int k0 = 64 * kb, n0 = 64 * nb;
    const int lr = lane >> 4, lc = (lane & 15) * 4;
#pragma unroll 4
    for (int i = 0; i < 16; ++i) { const int kk = 4 * i + lr; const f32x4 v = *(const f32x4*)(W + (size_t)(k0 + kk) * ldw + n0 + lc);
        LAS float* s = scr + kk * 65 + lc; s[0] = v[0]; s[1] = v[1]; s[2] = v[2]; s[3] = v[3]; }
    asm volatile("s_waitcnt lgkmcnt(0)" ::: "memory");
    const int c = lane & 7;
#pragma unroll
    for (int j = 0; j < 8; ++j) { const int n = (lane >> 3) + 8 * j; const LAS float* s = scr + (8 * c) * 65 + n;
        v4u o; o.x = pk2(s[0 * 65], s[1 * 65]); o.y = pk2(s[2 * 65], s[3 * 65]); o.z = pk2(s[4 * 65], s[5 * 65]); o.w = pk2(s[6 * 65], s[7 * 65]);
        *(v4u*)(WT + (size_t)drow_map<MODE>(n0 + n) * 1024 + k0 + 8 * c) = o; }
    asm volatile("s_waitcnt lgkmcnt(0)" ::: "memory");
}
DI void p0_convert(KA a, LAS unsigned char* lds, int lane, int wave, int vcu, int G) {
    LAS float* scr = (LAS float*)(lds + wave * 16640);
    const int gw = vcu * 8 + wave, NGW = G * 8;
    unsigned char* ws = a->ws;
    constexpr int I_WIN = 16 * 64, I_SQ = 16 * 16;
    constexpr int NITEMS = I_WIN + 5 * I_SQ + 192 * I_SQ;
    for (int it = gw; it < NITEMS; it += NGW) {
        int r = it;
        if (r < I_WIN) { transpose_item<0>(a->in[I_AWIN], AIN, (bf16*)(ws + WS_WIN), r >> 6, r & 63, scr, lane); continue; }
        r -= I_WIN;
        const int mid = r >> 8, sub = r & 255, kb = sub >> 4, nb = sub & 15;
        if (mid == 0) { transpose_item<0>(a->in[I_AWOUT], 1024, (bf16*)(ws + WS_WOA), kb, nb, scr, lane); continue; }
        if (mid == 1) { transpose_item<1>(a->in[I_BWK], 1024, (bf16*)(ws + WS_WKV), kb, nb, scr, lane); continue; }
        if (mid == 2) { transpose_item<1>(a->in[I_BWV], 1024, (bf16*)(ws + WS_WKV) + (size_t)1024 * 1024, kb, nb, scr, lane); continue; }
        if (mid == 3) { transpose_item<1>(a->in[I_BWQ], 1024, (bf16*)(ws + WS_WQ), kb, nb, scr, lane); continue; }
        if (mid == 4) { transpose_item<0>(a->in[I_BWOUT], 1024, (bf16*)(ws + WS_WOB), kb, nb, scr, lane); continue; }
        const int mm = mid - 5, le = mm / 3, which = mm - le * 3;
        if (which == 0) transpose_item<2>(a->in[I_WG] + (size_t)le * 1048576, 1024, (bf16*)(ws + WS_WGU) + (size_t)le * 2097152, kb, nb, scr, lane);
        else if (which == 1) transpose_item<3>(a->in[I_WU] + (size_t)le * 1048576, 1024, (bf16*)(ws + WS_WGU) + (size_t)le * 2097152, kb, nb, scr, lane);
        else transpose_item<0>(a->in[I_WDN] + (size_t)le * 1048576, 1024, (bf16*)(ws + WS_WD) + (size_t)le * 1048576, kb, nb, scr, lane);
    }
}

DI void store_bf16_row(bf16* orow, int lane, const f32x4 (&v)[4]) {
    unsigned long long* o8 = (unsigned long long*)orow + lane;
#pragma unroll
    for (int j = 0; j < 4; ++j) o8[64 * j] = (unsigned long long)pk2(v[j][0], v[j][1]) | ((unsigned long long)pk2(v[j][2], v[j][3]) << 32);
}
DI void modulate_row(f32x4 (&v)[4], const float* shift, const float* scale, int lane) {
    float s = 0.f;
#pragma unroll
    for (int j = 0; j < 4; ++j) s += (v[j][0] * v[j][0] + v[j][1] * v[j][1]) + (v[j][2] * v[j][2] + v[j][3] * v[j][3]);
    const float rn = rsqrtf(wave_sum(s) * (1.0f / 1024.0f) + EPS);
#pragma unroll
    for (int j = 0; j < 4; ++j) { const f32x4 sh = *(const f32x4*)(shift + 4 * lane + 256 * j), sc = *(const f32x4*)(scale + 4 * lane + 256 * j); v[j] = v[j] * rn * (sc + 1.0f) + sh; }
}

DI void p1_norm1(KA a, LAS unsigned char* lds, int tid, int lane, int wave, int vcu, int G) {
    LAS float* wsm = (LAS float*)lds;
    const float* win = a->in[I_AWIN];
    for (int i = tid; i < 1024 * 16; i += 512) { const int k = i >> 4, jj = i & 15; const int l = (k >> 2) & 63, j = k >> 8, c = k & 3;
        wsm[(((j * 4 + c) * 4 + (jj >> 2)) * 64 + l) * 4 + (jj & 3)] = win[(size_t)k * AIN + 4096 + jj]; }
    __syncthreads();
    const float* MODV = (const float*)(a->ws + WS_MODV);
    bf16* XN = (bf16*)(a->ws + WS_XN);
    float* BETA = (float*)(a->ws + WS_BETA); float* GDEC = (float*)(a->ws + WS_GDEC);
    const int gw = vcu * 8 + wave, NGW = G * 8;
    for (int m0 = gw * 4; m0 < NTOK; m0 += NGW * 4) {
        const int b = m0 >> 11; const float* shift = MODV + (size_t)b * MODW; const float* scale = shift + 1024;
        float acc[64];
#pragma unroll
        for (int i = 0; i < 64; ++i) acc[i] = 0.f;
#pragma unroll
        for (int rp = 0; rp < 2; ++rp) {
            f32x4 v[2][4];
#pragma unroll
            for (int r2 = 0; r2 < 2; ++r2) { const int r = 2 * rp + r2; const f32x4* xr = (const f32x4*)(a->in[I_X] + (size_t)(m0 + r) * 1024) + lane;
#pragma unroll
                for (int j = 0; j < 4; ++j) v[r2][j] = xr[64 * j];
                modulate_row(v[r2], shift, scale, lane);
                store_bf16_row(XN + (size_t)(m0 + r) * 1024, lane, v[r2]); }
#pragma unroll
            for (int j = 0; j < 4; ++j)
#pragma unroll
                for (int c = 0; c < 4; ++c) {
#pragma unroll
                    for (int q = 0; q < 4; ++q) { const f32x4 w = *(const LAS f32x4*)(wsm + (((j * 4 + c) * 4 + q) * 64 + lane) * 4);
#pragma unroll
                        for (int r2 = 0; r2 < 2; ++r2) { const float xv = v[r2][j][c]; const int r = 2 * rp + r2;
                            acc[r * 16 + 4 * q + 0] += xv * w[0]; acc[r * 16 + 4 * q + 1] += xv * w[1]; acc[r * 16 + 4 * q + 2] += xv * w[2]; acc[r * 16 + 4 * q + 3] += xv * w[3]; } }
                    asm volatile("" ::: "memory"); __builtin_amdgcn_sched_barrier(0); }
        }
        const float val = rs64(acc, lane);
        const int tok = m0 + (lane >> 4), jj = lane & 15;
        if (jj < 8) BETA[tok * 8 + jj] = sigmoid_f(val);
        else { const int h = jj - 8; GDEC[tok * 8 + h] = -__expf(a->in[I_ALOG][h]) * softplus_f(val + a->in[I_ADT][h]); }
    }
}

DI void p3_delta_naive(KA a, LAS unsigned char* lds, int tid, int lane, int wave) {
    const bf16* PROJ = (const bf16*)(a->ws + WS_PROJ);
    const float* BETA = (const float*)(a->ws + WS_BETA); const float* GDEC = (const float*)(a->ws + WS_GDEC);
    bf16* OD = (bf16*)(a->ws + WS_OD);
    LAS float* buf = (LAS float*)lds;
    LAS float* gb = (LAS float*)(lds + 4096);
    for (int unit = blockIdx.x; unit < 64; unit += gridDim.x) {
        const int b = unit >> 3, h = unit & 7;
        __syncthreads();
        for (int s = tid; s < SEQ; s += 512) { gb[2 * s] = GDEC[(size_t)(b * SEQ + s) * 8 + h]; gb[2 * s + 1] = BETA[(size_t)(b * SEQ + s) * 8 + h]; }
        float S[64];
#pragma unroll
        for (int d = 0; d < 64; ++d) S[d] = 0.f;
        const int which = tid >> 7, c = tid & 127, col = (which < 3 ? which : 0) * 1024 + h * 128 + c;
        const float cw0 = a->in[I_ACONV][col], cw1 = a->in[I_ACONV][3072 + col], cw2 = a->in[I_ACONV][2 * 3072 + col], cw3 = a->in[I_ACONV][3 * 3072 + col];
        float p0 = 0.f, p1 = 0.f, p2 = 0.f;
        const bf16* pc = PROJ + (size_t)b * SEQ * 4096 + col;
        float pn = bf2f(pc[0]);
        const int se = wave * 32 + (lane & 31), dh = (lane >> 5) * 64;
        for (int s = 0; s < SEQ; ++s) {
            LAS float* cur = buf + (s & 1) * 512;
            const float pnow = pn;
            if (s + 1 < SEQ) pn = bf2f(pc[(size_t)(s + 1) * 4096]);
            const float val = silu_f(cw0 * p0 + cw1 * p1 + cw2 * p2 + cw3 * pnow); p0 = p1; p1 = p2; p2 = pnow;
            const float ss = wave_sum(val * val);
            if (tid < 384) cur[tid] = val;
            if (wave < 4 && lane == 0) cur[384 + wave] = ss;
            __syncthreads();
            if (wave < 4) {
                const float ssq = cur[384] + cur[385], ssk = cur[386] + cur[387];
                const float qsc = rsqrtf(ssq + EPS) * 0.08838834764831845f, ksc = rsqrtf(ssk + EPS);
                const float al = __expf(gb[2 * s]), bt = gb[2 * s + 1];
                float kv = 0.f;
#pragma unroll
                for (int d = 0; d < 64; d += 4) { const f32x4 kk = *(const LAS f32x4*)(cur + 128 + dh + d);
                    S[d] *= al; S[d + 1] *= al; S[d + 2] *= al; S[d + 3] *= al;
                    kv += S[d] * kk[0] + S[d + 1] * kk[1] + S[d + 2] * kk[2] + S[d + 3] * kk[3]; }
                kv += __shfl_xor(kv, 32);
                const float coef = ksc * bt * (cur[256 + se] - ksc * kv);
                float o = 0.f;
#pragma unroll
                for (int d = 0; d < 64; d += 4) { const f32x4 kk = *(const LAS f32x4*)(cur + 128 + dh + d), qq = *(const LAS f32x4*)(cur + dh + d);
                    S[d] += kk[0] * coef; S[d + 1] += kk[1] * coef; S[d + 2] += kk[2] * coef; S[d + 3] += kk[3] * coef;
                    o += S[d] * qq[0] + S[d + 1] * qq[1] + S[d + 2] * qq[2] + S[d + 3] * qq[3]; }
                o += __shfl_xor(o, 32);
                if (lane < 32) OD[(size_t)(b * SEQ + s) * 1024 + h * 128 + se] = (bf16)f2bf(o * qsc);
            }
        }
    }
}


typedef float f32x16 __attribute__((ext_vector_type(16)));
typedef short s16x4 __attribute__((ext_vector_type(4)));
DI s16x4 lds_tr16_b64(const LAS unsigned char* p) { typedef short v4i16_t __attribute__((ext_vector_type(4)));
    return __builtin_bit_cast(s16x4, __builtin_amdgcn_ds_read_tr16_b64_v4i16((LAS v4i16_t*)p)); }
DI bf16x8 cat8(v2u lo, v2u hi) { v4u t; t.x = lo.x; t.y = lo.y; t.z = hi.x; t.w = hi.y; return __builtin_bit_cast(bf16x8, t); }
DI bf16x8 pack8(const f32x4& a, const f32x4& b) { v4u t; t.x = pg8::cvt_pk_bf16(a[0], a[1]); t.y = pg8::cvt_pk_bf16(a[2], a[3]); t.z = pg8::cvt_pk_bf16(b[0], b[1]); t.w = pg8::cvt_pk_bf16(b[2], b[3]); return __builtin_bit_cast(bf16x8, t); }

constexpr int D3_P = 272;
constexpr int D3_LP = 68  , D3_PL = 144;
constexpr int D3_G = 0, D3_TH = 1024, D3_TL = 3072, D3_LH = 5120, D3_LL = D3_LH + 64 * D3_PL, D3_L = D3_LL + 64 * D3_PL, D3_Q = D3_L + 64 * D3_LP * 4, D3_K = D3_Q + 64 * D3_P, D3_V = D3_K + 64 * D3_P;
DI void p3_chunk_local(KA a, LAS unsigned char* lds, int tid, int lane, int wave, int vcu, int G) {
    const bf16* PROJ = (const bf16*)(a->ws + WS_PROJ);
    const float* BETA = (const float*)(a->ws + WS_BETA); const float* GDEC = (const float*)(a->ws + WS_GDEC);
    bf16* QN = (bf16*)(a->ws + WS_QN); bf16* KN = (bf16*)(a->ws + WS_KN); bf16* WW = (bf16*)(a->ws + WS_WW); bf16* UUT = (bf16*)(a->ws + WS_UUT); bf16* QKM = (bf16*)(a->ws + WS_QKM);
    float* GC = (float*)(a->ws + WS_GC);
    LAS float* Lm = (LAS float*)(lds + D3_L); LAS float* gcs = (LAS float*)(lds + D3_G); LAS float* bts = gcs + 64; LAS float* egs = gcs + 128;
    const float* cw = a->in[I_ACONV];
    for (int unit = vcu; unit < 2048; unit += G) {
        const int b = unit >> 8, h = (unit >> 5) & 7, n = unit & 31;
        const size_t t0 = (size_t)b * SEQ + n * 64;
        {
            const int r0 = 8 * wave;
#pragma unroll
            for (int which = 0; which < 3; ++which) {
                const int col = which * 1024 + h * 128 + 2 * lane;
                float w0[4], w1[4];
#pragma unroll
                for (int j = 0; j < 4; ++j) { const f32x2 t = *(const f32x2*)(cw + j * 3072 + col); w0[j] = t[0]; w1[j] = t[1]; }
                float x0[11], x1[11];
#pragma unroll
                for (int rr = 0; rr < 11; ++rr) { const int sl = n * 64 + r0 + rr - 3;
                    unsigned v = 0u; if (sl >= 0) v = *(const unsigned*)(PROJ + ((size_t)b * SEQ + sl) * 4096 + col);
                    x0[rr] = bflo(v); x1[rr] = bfhi(v); }
#pragma unroll
                for (int i = 0; i < 8; ++i) {
                    float o0 = w0[0] * x0[i] + w0[1] * x0[i + 1] + w0[2] * x0[i + 2] + w0[3] * x0[i + 3];
                    float o1 = w1[0] * x1[i] + w1[1] * x1[i + 1] + w1[2] * x1[i + 2] + w1[3] * x1[i + 3];
                    o0 = silu_f(o0); o1 = silu_f(o1);
                    if (which < 2) { const float ss = wave_sum(o0 * o0 + o1 * o1); const float sc = rsqrtf(ss + EPS) * (which == 0 ? 0.08838834764831845f : 1.0f); o0 *= sc; o1 *= sc; }
                    const unsigned pk = pk2(o0, o1);
                    *(LAS unsigned*)(lds + D3_Q + which * (64 * D3_P) + (r0 + i) * D3_P + 4 * lane) = pk;
                    if (which == 0) *(unsigned*)(QN + (t0 + r0 + i) * 1024 + h * 128 + 2 * lane) = pk;
                    if (which == 1) *(unsigned*)(KN + (t0 + r0 + i) * 1024 + h * 128 + 2 * lane) = pk;
                }
            }
        }
        if (wave == 0) {
            float g = GDEC[(t0 + lane) * 8 + h]; const float bt = BETA[(t0 + lane) * 8 + h];
#pragma unroll
            for (int off = 1; off < 64; off <<= 1) { const float t = __shfl_up(g, off); if (lane >= off) g += t; }
            gcs[lane] = g; bts[lane] = bt; egs[lane] = __expf(g); GC[(t0 + lane) * 8 + h] = g;
        }
        __syncthreads();
        {
            const int kind = wave >> 2, ti = (wave >> 1) & 1, tj = wave & 1, r32 = lane & 31, hh = lane >> 5;
            f32x16 acc;
#pragma unroll
            for (int i = 0; i < 16; ++i) acc[i] = 0.f;
            if (ti >= tj) {
                const LAS unsigned char* Ab = lds + (kind ? D3_Q : D3_K) + (32 * ti + r32) * D3_P + 16 * hh;
                const LAS unsigned char* Bb = lds + D3_K + (32 * tj + r32) * D3_P + 16 * hh;
#pragma unroll
                for (int kk = 0; kk < 8; ++kk) { const bf16x8 av = *(const LAS bf16x8*)(Ab + 32 * kk), bv = *(const LAS bf16x8*)(Bb + 32 * kk);
                    acc = __builtin_amdgcn_mfma_f32_32x32x16_bf16(av, bv, acc, 0, 0, 0); }
            }
            const int j = 32 * tj + r32; const float gj = gcs[j];
            bf16* qkm = QKM + (size_t)unit * 4096;
#pragma unroll
            for (int reg = 0; reg < 16; ++reg) { const int i = 32 * ti + (reg & 3) + 8 * (reg >> 2) + 4 * hh;
                const float dec = (i >= j) ? __expf(gcs[i] - gj) : 0.f;
                if (kind == 0) { const float v = (i > j) ? bts[i] * acc[reg] * dec : 0.f; Lm[i * D3_LP + j] = v;
                    const unsigned nh = f2bf(-v); const unsigned nl = f2bf(-v - bf2f(nh));
                    *(LAS unsigned short*)(lds + D3_LH + i * D3_PL + 2 * j) = (unsigned short)nh; *(LAS unsigned short*)(lds + D3_LL + i * D3_PL + 2 * j) = (unsigned short)nl; }
                else qkm[i * 64 + j] = (bf16)f2bf(acc[reg] * dec); }
        }
        __syncthreads();
        if (wave == 0) {
            const int bb = lane >> 4, c = lane & 15;
            const LAS float* Lb = Lm + (16 * bb) * D3_LP + 16 * bb; asm volatile("" : "+v"(Lb));
            float t[16];
#pragma unroll
            for (int i = 0; i < 16; ++i) t[i] = 0.f;
#pragma unroll
            for (int i = 0; i < 16; ++i) {
                float r = (i == c) ? 1.f : 0.f;
#pragma unroll
                for (int jj = 0; jj < (i + 3) / 4; ++jj) { const f32x4 l4 = *(const LAS f32x4*)(Lb + i * D3_LP + 4 * jj);
                    r -= l4[0] * t[4 * jj]; r -= l4[1] * t[4 * jj + 1]; r -= l4[2] * t[4 * jj + 2]; r -= l4[3] * t[4 * jj + 3]; }
                t[i] = r;
                const unsigned th = f2bf(r); const unsigned tl = f2bf(r - bf2f(th));
                *(LAS unsigned short*)(lds + D3_TH + (bb * 16 + i) * 32 + 2 * c) = (unsigned short)th; *(LAS unsigned short*)(lds + D3_TL + (bb * 16 + i) * 32 + 2 * c) = (unsigned short)tl;
            }
        }
        __syncthreads();
        {
            const int g = lane >> 4, r16 = lane & 15;
#pragma unroll
            for (int q = 0; q < 2; ++q) {
                const int nt = 2 * wave + q, isw = nt >> 3, c = 16 * (nt & 7) + r16;
                const LAS unsigned char* src = lds + (isw ? D3_K : D3_V) + 2 * c + 4 * g * D3_P; asm volatile("" : "+v"(src));
                const LAS unsigned char* lhb = lds + D3_LH + r16 * D3_PL + 8 * g; asm volatile("" : "+v"(lhb));
                const LAS unsigned char* thb = lds + D3_TH + r16 * 32 + 8 * g; asm volatile("" : "+v"(thb));
                const LAS float* gb4 = bts + 4 * g; asm volatile("" : "+v"(gb4));
                s16x4 Xh[4], Xl[4]; f32x4 X[4];
#pragma unroll
                for (int b4 = 0; b4 < 4; ++b4) {
                    f32x4 acc;
#pragma unroll
                    for (int r = 0; r < 4; ++r) { float v = bf2f(*(const LAS unsigned short*)(src + (16 * b4 + r) * D3_P)) * gb4[16 * b4 + r]; const float ev = gb4[64 + 16 * b4 + r]; v *= isw ? ev : 1.0f; acc[r] = v; }
#pragma unroll
                    for (int bj = 0; bj < b4; ++bj) {
                        const s16x4 ah = *(const LAS s16x4*)(lhb + (16 * b4) * D3_PL + 32 * bj);
                        const s16x4 al = *(const LAS s16x4*)(lhb + (D3_LL - D3_LH) + (16 * b4) * D3_PL + 32 * bj);
                        acc = __builtin_amdgcn_mfma_f32_16x16x16bf16_1k(ah, Xh[bj], acc, 0, 0, 0);
                        acc = __builtin_amdgcn_mfma_f32_16x16x16bf16_1k(ah, Xl[bj], acc, 0, 0, 0);
                        acc = __builtin_amdgcn_mfma_f32_16x16x16bf16_1k(al, Xh[bj], acc, 0, 0, 0);
                    }
                    s16x4 ch, cl;
#pragma unroll
                    for (int r = 0; r < 4; ++r) { const unsigned hi = f2bf(acc[r]); ch[r] = (short)hi; cl[r] = (short)f2bf(acc[r] - bf2f(hi)); }
                    const s16x4 th = *(const LAS s16x4*)(thb + b4 * 512);
                    const s16x4 tl = *(const LAS s16x4*)(thb + (D3_TL - D3_TH) + b4 * 512);
                    f32x4 x = (f32x4){0.f, 0.f, 0.f, 0.f};
                    x = __builtin_amdgcn_mfma_f32_16x16x16bf16_1k(th, ch, x, 0, 0, 0);
                    x = __builtin_amdgcn_mfma_f32_16x16x16bf16_1k(th, cl, x, 0, 0, 0);
                    x = __builtin_amdgcn_mfma_f32_16x16x16bf16_1k(tl, ch, x, 0, 0, 0);
                    X[b4] = x;
#pragma unroll
                    for (int r = 0; r < 4; ++r) { const unsigned hi = f2bf(x[r]); Xh[b4][r] = (short)hi; Xl[b4][r] = (short)f2bf(x[r] - bf2f(hi)); }
                }
                if (isw) {
#pragma unroll
                    for (int b4 = 0; b4 < 4; ++b4)
#pragma unroll
                        for (int r = 0; r < 4; ++r) WW[(t0 + 16 * b4 + 4 * g + r) * 1024 + h * 128 + c] = (bf16)(unsigned short)Xh[b4][r];
                } else {
#pragma unroll
                    for (int b4 = 0; b4 < 4; ++b4) *(s16x4*)(UUT + ((size_t)unit * 128 + c) * 64 + 16 * b4 + 4 * g) = Xh[b4];
                }
            }
        }
        __syncthreads();
    }
}

constexpr int D4_PW = 272, D4_PK = 288, D4_PQK = 144;
constexpr int D4_W = 0, D4_Q = 64 * D4_PW, D4_K = 2 * 64 * D4_PW, D4_QK = D4_K + 64 * D4_PK, D4_G = D4_QK + 64 * D4_PQK, D4_BUF = D4_G + 256;
DI void p4_recurrence(KA a, LAS unsigned char* lds, int tid, int lane, int wave) {
    const int bx = blockIdx.x; if ((bx >> 3) >= 8) return;
    const int bh = (bx & 7) * 8 + (bx >> 3), b = bh >> 3, h = bh & 7;
    const bf16* QN = (const bf16*)(a->ws + WS_QN); const bf16* KN = (const bf16*)(a->ws + WS_KN); const bf16* WW = (const bf16*)(a->ws + WS_WW);
    const bf16* UUT = (const bf16*)(a->ws + WS_UUT); const bf16* QKM = (const bf16*)(a->ws + WS_QKM); const float* GC = (const float*)(a->ws + WS_GC);
    bf16* OD = (bf16*)(a->ws + WS_OD);
    const int g = lane >> 4, r16 = lane & 15;
    const int srow0 = tid >> 4, scol = tid & 15, qrow = tid >> 3, qcol = tid & 7;
    v4u rw[2], rq[2], rk[2], rqk; float rg = 0.f; v2u ru[4];
#define D4_LOAD(nn) do { const size_t tt = (size_t)b * SEQ + (nn) * 64; const int un = (b * 8 + h) * 32 + (nn); \
        _Pragma("unroll") for (int i = 0; i < 2; ++i) { const size_t go = (tt + srow0 + 32 * i) * 1024 + h * 128 + scol * 8; \
            rw[i] = *(const v4u*)(WW + go); rq[i] = *(const v4u*)(QN + go); rk[i] = *(const v4u*)(KN + go); } \
        rqk = *(const v4u*)(QKM + (size_t)un * 4096 + qrow * 64 + qcol * 8); \
        if (tid < 64) rg = GC[(tt + tid) * 8 + h]; \
        _Pragma("unroll") for (int mt = 0; mt < 4; ++mt) ru[mt] = *(const v2u*)(UUT + ((size_t)un * 128 + 16 * wave + r16) * 64 + 16 * mt + 4 * g); } while (0)
#define D4_STORE(bufo) do { LAS unsigned char* B_ = lds + (bufo); \
        _Pragma("unroll") for (int i = 0; i < 2; ++i) { *(LAS v4u*)(B_ + D4_W + (srow0 + 32 * i) * D4_PW + scol * 16) = rw[i]; *(LAS v4u*)(B_ + D4_Q + (srow0 + 32 * i) * D4_PW + scol * 16) = rq[i]; \
            *(LAS v4u*)(B_ + D4_K + (srow0 + 32 * i) * D4_PK + scol * 16) = rk[i]; } \
        *(LAS v4u*)(B_ + D4_QK + qrow * D4_PQK + qcol * 16) = rqk; \
        if (tid < 64) *(LAS float*)(B_ + D4_G + 4 * tid) = rg; } while (0)
    f32x4 S[8];
#pragma unroll
    for (int dt = 0; dt < 8; ++dt) S[dt] = (f32x4){0.f, 0.f, 0.f, 0.f};
    D4_LOAD(0);
    v2u ucur[4];
#pragma unroll
    for (int mt = 0; mt < 4; ++mt) ucur[mt] = ru[mt];
    D4_STORE(0);
    __syncthreads();
    for (int n = 0; n < 32; ++n) {
        const LAS unsigned char* B = lds + (n & 1) * D4_BUF;
        if (n + 1 < 32) D4_LOAD(n + 1);
        const LAS float* gcs = (const LAS float*)(B + D4_G);
        const float gl = gcs[63], egl = __expf(gl);
        bf16x8 Sb[4];
#pragma unroll
        for (int s = 0; s < 4; ++s) Sb[s] = pack8(S[2 * s], S[2 * s + 1]);
        f32x4 Vn[4], O[4];
#pragma unroll
        for (int mt = 0; mt < 4; ++mt) {
            f32x4 av; av[0] = -bflo(ucur[mt].x); av[1] = -bfhi(ucur[mt].x); av[2] = -bflo(ucur[mt].y); av[3] = -bfhi(ucur[mt].y);
            f32x4 ao = (f32x4){0.f, 0.f, 0.f, 0.f};
            const LAS unsigned char* wr_ = B + D4_W + (16 * mt + r16) * D4_PW + 8 * g;
            const LAS unsigned char* qr_ = B + D4_Q + (16 * mt + r16) * D4_PW + 8 * g;
#pragma unroll
            for (int s = 0; s < 4; ++s) {
                const bf16x8 wa = cat8(*(const LAS v2u*)(wr_ + 64 * s), *(const LAS v2u*)(wr_ + 64 * s + 32));
                const bf16x8 qa = cat8(*(const LAS v2u*)(qr_ + 64 * s), *(const LAS v2u*)(qr_ + 64 * s + 32));
                av = __builtin_amdgcn_mfma_f32_16x16x32_bf16(wa, Sb[s], av, 0, 0, 0);
                ao = __builtin_amdgcn_mfma_f32_16x16x32_bf16(qa, Sb[s], ao, 0, 0, 0);
            }
            Vn[mt] = -av;
            const f32x4 eg = *(const LAS f32x4*)(gcs + 16 * mt + 4 * g);
            O[mt][0] = ao[0] * __expf(eg[0]); O[mt][1] = ao[1] * __expf(eg[1]); O[mt][2] = ao[2] * __expf(eg[2]); O[mt][3] = ao[3] * __expf(eg[3]);
        }
        bf16x8 Vb[2];
#pragma unroll
        for (int s2 = 0; s2 < 2; ++s2) Vb[s2] = pack8(Vn[2 * s2], Vn[2 * s2 + 1]);
#pragma unroll
        for (int mt = 0; mt < 4; ++mt) {
            const LAS unsigned char* kr_ = B + D4_QK + (16 * mt + r16) * D4_PQK + 8 * g;
#pragma unroll
            for (int s2 = 0; s2 < 2; ++s2) { const bf16x8 qa = cat8(*(const LAS v2u*)(kr_ + 64 * s2), *(const LAS v2u*)(kr_ + 64 * s2 + 32));
                O[mt] = __builtin_amdgcn_mfma_f32_16x16x32_bf16(qa, Vb[s2], O[mt], 0, 0, 0); }
        }
        { const size_t tt = (size_t)b * SEQ + n * 64;
#pragma unroll
          for (int mt = 0; mt < 4; ++mt)
#pragma unroll
              for (int r = 0; r < 4; ++r) OD[(tt + 16 * mt + 4 * g + r) * 1024 + h * 128 + 16 * wave + r16] = (bf16)f2bf(O[mt][r]); }
#pragma unroll
        for (int mt = 0; mt < 4; ++mt) { const f32x4 eg = *(const LAS f32x4*)(gcs + 16 * mt + 4 * g);
            Vn[mt][0] *= __expf(gl - eg[0]); Vn[mt][1] *= __expf(gl - eg[1]); Vn[mt][2] *= __expf(gl - eg[2]); Vn[mt][3] *= __expf(gl - eg[3]); }
#pragma unroll
        for (int s2 = 0; s2 < 2; ++s2) Vb[s2] = pack8(Vn[2 * s2], Vn[2 * s2 + 1]);
#pragma unroll
        for (int dt = 0; dt < 8; ++dt) {
            f32x4 acc = S[dt] * egl;
#pragma unroll
            for (int s2 = 0; s2 < 2; ++s2) {
                const LAS unsigned char* kb_ = B + D4_K + (32 * s2 + 4 * g + (r16 >> 2)) * D4_PK + (16 * dt + 4 * (r16 & 3)) * 2;
                const s16x4 lo = lds_tr16_b64(kb_), hi = lds_tr16_b64(kb_ + 16 * D4_PK);
                const bf16x8 ka = __builtin_shufflevector(lo, hi, 0, 1, 2, 3, 4, 5, 6, 7);
                acc = __builtin_amdgcn_mfma_f32_16x16x32_bf16(ka, Vb[s2], acc, 0, 0, 0);
            }
            S[dt] = acc;
        }
        if (n + 1 < 32) {
#pragma unroll
            for (int mt = 0; mt < 4; ++mt) ucur[mt] = ru[mt];
            D4_STORE(((n + 1) & 1) * D4_BUF);
        }
        __syncthreads();
    }
#undef D4_LOAD
#undef D4_STORE
}

DI void p5_gated_norm(KA a, int lane, int wave, int vcu, int G) {
    const bf16* OD = (const bf16*)(a->ws + WS_OD); const bf16* PROJ = (const bf16*)(a->ws + WS_PROJ); bf16* ON = (bf16*)(a->ws + WS_ON);
    const int gw = vcu * 8 + wave, NGW = G * 8;
    float nw[16];
#pragma unroll
    for (int i = 0; i < 16; ++i) nw[i] = a->in[I_ANORM][(16 * lane + i) & 127];
    for (int m = gw; m < NTOK; m += NGW) {
        const v4u o0 = *(const v4u*)(OD + (size_t)m * 1024 + 16 * lane), o1 = *(const v4u*)(OD + (size_t)m * 1024 + 16 * lane + 8);
        const v4u z0 = *(const v4u*)(PROJ + (size_t)m * 4096 + 3072 + 16 * lane), z1 = *(const v4u*)(PROJ + (size_t)m * 4096 + 3072 + 16 * lane + 8);
        float o[16], z[16];
#pragma unroll
        for (int i = 0; i < 4; ++i) { o[2 * i] = bflo(o0[i]); o[2 * i + 1] = bfhi(o0[i]); o[8 + 2 * i] = bflo(o1[i]); o[8 + 2 * i + 1] = bfhi(o1[i]);
            z[2 * i] = bflo(z0[i]); z[2 * i + 1] = bfhi(z0[i]); z[8 + 2 * i] = bflo(z1[i]); z[8 + 2 * i + 1] = bfhi(z1[i]); }
        float ss = 0.f;
#pragma unroll
        for (int i = 0; i < 16; ++i) ss += o[i] * o[i];
        ss += __shfl_xor(ss, 1); ss += __shfl_xor(ss, 2); ss += __shfl_xor(ss, 4);
        const float rn = rsqrtf(ss * (1.0f / 128.0f) + EPS);
        float r[16];
#pragma unroll
        for (int i = 0; i < 16; ++i) r[i] = o[i] * rn * nw[i] * silu_f(z[i]);
        v4u w0, w1;
#pragma unroll
        for (int i = 0; i < 4; ++i) { w0[i] = pk2(r[2 * i], r[2 * i + 1]); w1[i] = pk2(r[8 + 2 * i], r[8 + 2 * i + 1]); }
        *(v4u*)(ON + (size_t)m * 1024 + 16 * lane) = w0; *(v4u*)(ON + (size_t)m * 1024 + 16 * lane + 8) = w1;
    }
}

DI void p7_router(KA a, LAS unsigned char* lds, int layer, int tid, int lane, int wave, int vcu, int G) {
    LAS float* wr_l = (LAS float*)lds;
    LAS int* lcnt = (LAS int*)(lds + TAB_OFF);
    LAS int* lbase = lcnt + 32;
    LAS int* tsel = (LAS int*)(lds + TAB_OFF + 512);
    LAS float* tgate = (LAS float*)(lds + TAB_OFF + 512 + 1024);
    const float* wrt = a->in[I_WR] + (size_t)layer * 1024 * 32;
    for (int i = tid; i < 1024 * 32; i += 512) { const int k = i >> 5, e = i & 31; const int l = (k >> 2) & 63, j = k >> 8, c = k & 3;
        wr_l[(((j * 4 + c) * 8 + (e >> 2)) * 64 + l) * 4 + (e & 3)] = wrt[i]; }
    if (tid < 32) lcnt[tid] = 0;
    __syncthreads();
    const float* MODV = (const float*)(a->ws + WS_MODV);
    bf16* XN = (bf16*)(a->ws + WS_XN);
    const float* hbuf = a->out;
    int* SEL = (int*)(a->ws + WS_SEL); int* POS = (int*)(a->ws + WS_POS); float* GATE = (float*)(a->ws + WS_GATE); int* LIST = (int*)(a->ws + WS_LIST);
    unsigned* gcnt = (unsigned*)(a->ws + WS_CTL) + CW_CNT + layer * 32 * 16;
    const float bias = a->in[I_BR][layer * 32 + (lane & 31)];
    for (int grp = vcu; grp < NTOK / 64; grp += G) {
        const int t0 = grp * 64 + wave * 8;
#pragma unroll 1
        for (int pr = 0; pr < 4; ++pr) {
            const int m0 = t0 + 2 * pr; const int b = m0 >> 11;
            const float* shift = MODV + (size_t)b * MODW + layer * 6144 + 3072; const float* scale = shift + 1024;
            float acc[64];
#pragma unroll
            for (int i = 0; i < 64; ++i) acc[i] = 0.f;
#pragma unroll
            for (int r = 0; r < 2; ++r) {
                f32x4 v[4]; const f32x4* xr = (const f32x4*)(hbuf + (size_t)(m0 + r) * 1024) + lane;
#pragma unroll
                for (int j = 0; j < 4; ++j) v[j] = xr[64 * j];
                modulate_row(v, shift, scale, lane);
                store_bf16_row(XN + (size_t)(m0 + r) * 1024, lane, v);
#pragma unroll
                for (int j = 0; j < 4; ++j)
#pragma unroll
                    for (int c = 0; c < 4; ++c)
                    { _Pragma("unroll") for (int q = 0; q < 8; ++q) { const f32x4 w = *(const LAS f32x4*)(wr_l + (((j * 4 + c) * 8 + q) * 64 + lane) * 4); const float xv = v[j][c];
                            acc[r * 32 + 4 * q + 0] += xv * w[0]; acc[r * 32 + 4 * q + 1] += xv * w[1]; acc[r * 32 + 4 * q + 2] += xv * w[2]; acc[r * 32 + 4 * q + 3] += xv * w[3]; }
                      __builtin_amdgcn_sched_barrier(0); }
            }
            float val = rs64(acc, lane) + bias;
            const int e = lane & 31; const int tl = wave * 8 + 2 * pr + (lane >> 5);
            float topv[4]; int topi[4];
#pragma unroll
            for (int k = 0; k < 4; ++k) {
                float mv = val; int mi = e;
#pragma unroll
                for (int off = 16; off >= 1; off >>= 1) { const float ov = __shfl_xor(mv, off); const int oi = __shfl_xor(mi, off); if (ov > mv || (ov == mv && oi < mi)) { mv = ov; mi = oi; } }
                topv[k] = mv; topi[k] = mi; if (e == mi) val = -3.0e38f;
            }
            const float e1 = __expf(topv[1] - topv[0]), e2 = __expf(topv[2] - topv[0]), e3 = __expf(topv[3] - topv[0]);
            const float inv = 1.0f / (1.0f + e1 + e2 + e3);
            const float gk[4] = {inv, e1 * inv, e2 * inv, e3 * inv};
#pragma unroll
            for (int k = 0; k < 4; ++k) if (e == topi[k]) { const int lp = __hip_atomic_fetch_add(&lcnt[e], 1, __ATOMIC_RELAXED, __HIP_MEMORY_SCOPE_WORKGROUP); tsel[tl * 4 + k] = e | (lp << 8); tgate[tl * 4 + k] = gk[k]; }
        }
        __syncthreads();
        if (tid < 32) { const int n = lcnt[tid]; lbase[tid] = n ? (int)__hip_atomic_fetch_add(gcnt + tid * 16, (unsigned)n, RLX_AGENT) : 0; }
        __syncthreads();
        if (tid < 256) { const int tl = tid >> 2, k = tid & 3; const int se = tsel[tl * 4 + k]; const int e = se & 255, pos = lbase[e] + (se >> 8); const int tok = grp * 64 + tl;
            SEL[tok * 4 + k] = e; POS[tok * 4 + k] = pos; GATE[tok * 4 + k] = tgate[tl * 4 + k]; LIST[e * NTOK + pos] = tok; }
        __syncthreads();
        if (tid < 32) lcnt[tid] = 0;
        __syncthreads();
    }
}

DI MoeTab moe_tables(KA a, LAS unsigned char* lds, int layer, int tid) {
    LAS int* cb = (LAS int*)(lds + TAB_OFF); LAS int* cnt = cb + 64;
    unsigned* gcnt = (unsigned*)(a->ws + WS_CTL) + CW_CNT + layer * 32 * 16;
    __syncthreads();
    if (tid == 0) { int s = 0; for (int e = 0; e < 32; ++e) { const int n = (int)__hip_atomic_load(gcnt + e * 16, RLX_AGENT); cnt[e] = n; cb[e] = s; s += (n + 255) >> 8; } cb[32] = s; cb[33] = 0x7fffffff; }
    __syncthreads();
    MoeTab T; T.cb = cb; T.cnt = cnt; T.total_rb = cb[32]; return T;
}

DI void p10_combine(KA a, LAS unsigned char* lds, int layer, int tid, int lane, int wave, int vcu, int G) {
    const MoeTab T = moe_tables(a, lds, layer, tid);
    const float* MODV = (const float*)(a->ws + WS_MODV);
    const bf16* Y = (const bf16*)(a->ws + WS_Y);
    const int* SEL = (const int*)(a->ws + WS_SEL); const int* POS = (const int*)(a->ws + WS_POS); const float* GATE = (const float*)(a->ws + WS_GATE);
    bf16* XN = (bf16*)(a->ws + WS_XN); bf16* XKV = (bf16*)(a->ws + WS_XKV);
    float* hbuf = a->out;
    const int gw = vcu * 8 + wave, NGW = G * 8;
    for (int m = gw; m < NTOK; m += NGW) {
        const int b = m >> 11; const float* mod = MODV + (size_t)b * MODW;
        f32x4 v[4], s[4];
#pragma unroll
        for (int j = 0; j < 4; ++j) { v[j] = *((const f32x4*)(hbuf + (size_t)m * 1024) + lane + 64 * j); s[j] = (f32x4){0.f, 0.f, 0.f, 0.f}; }
#pragma unroll
        for (int k = 0; k < 4; ++k) {
            const int e = SEL[m * 4 + k]; const size_t slot = (size_t)T.cb[e] * 256 + POS[m * 4 + k]; const float gt = GATE[m * 4 + k];
            const v2u* yr = (const v2u*)(Y + slot * 1024) + lane;
#pragma unroll
            for (int j = 0; j < 4; ++j) { const v2u w = yr[64 * j]; s[j][0] += gt * bflo(w[0]); s[j][1] += gt * bfhi(w[0]); s[j][2] += gt * bflo(w[1]); s[j][3] += gt * bfhi(w[1]); }
        }
#pragma unroll
        for (int j = 0; j < 4; ++j) { const f32x4 g2 = *(const f32x4*)(mod + layer * 6144 + 5 * 1024 + 4 * lane + 256 * j); v[j] = v[j] + g2 * s[j];
            *((f32x4*)(hbuf + (size_t)m * 1024) + lane + 64 * j) = v[j]; }
        if (layer == 0) {
            f32x4 t[4];
#pragma unroll
            for (int j = 0; j < 4; ++j) t[j] = v[j];
            modulate_row(t, mod + 12288, mod + 12288 + 1024, lane);
            store_bf16_row(XKV + (size_t)m * 1024, lane, t);
            modulate_row(v, mod + 6144, mod + 6144 + 1024, lane);
            store_bf16_row(XN + (size_t)m * 1024, lane, v);
        }
    }
}

DI void p12_attn_naive(KA a, LAS unsigned char* lds, int tid, int lane, int wave) {
    const bf16* QB = (const bf16*)(a->ws + WS_QB); const bf16* KSH = (const bf16*)(a->ws + WS_KSH); const bf16* VSH = (const bf16*)(a->ws + WS_VSH);
    bf16* ON = (bf16*)(a->ws + WS_ON);
    LAS float* Ks = (LAS float*)lds;
    LAS float* Vs = (LAS float*)(lds + 33792);
    LAS float* Ps = (LAS float*)(lds + 33792 + 32768);
    float lam;
    { float s1 = 0.f, s2 = 0.f; for (int i = 0; i < 64; ++i) { s1 += a->in[I_LQ1][i] * a->in[I_LK1][i]; s2 += a->in[I_LQ2][i] * a->in[I_LK2][i]; } lam = __expf(s1) - __expf(s2) + LAMBDA_INIT; }
    const int r = tid >> 3, p = tid & 7;
    for (int unit = blockIdx.x; unit < 2048; unit += gridDim.x) {
        const int b = unit >> 8, h = (unit >> 5) & 7, qc = unit & 31;
        const size_t tq = (size_t)b * SEQ + qc * 64 + r;
        float q0[64], q1[64];
        { const v4u* qp = (const v4u*)(QB + tq * 1024 + h * 128);
#pragma unroll
          for (int i = 0; i < 8; ++i) { const v4u w = qp[i], w1 = qp[8 + i];
#pragma unroll
              for (int j = 0; j < 4; ++j) { q0[8 * i + 2 * j] = bflo(w[j]); q0[8 * i + 2 * j + 1] = bfhi(w[j]); q1[8 * i + 2 * j] = bflo(w1[j]); q1[8 * i + 2 * j + 1] = bfhi(w1[j]); } } }
        float O0[16], O1[16], m0 = -1e30f, m1 = -1e30f, l0 = 0.f, l1 = 0.f;
#pragma unroll
        for (int i = 0; i < 16; ++i) { O0[i] = 0.f; O1[i] = 0.f; }
        for (int kt = 0; kt <= qc; ++kt) {
            __syncthreads();
            { const int j = tid >> 3, seg = (tid & 7) * 16; const size_t tk = (size_t)b * SEQ + kt * 64 + j;
              const v4u k0 = *(const v4u*)(KSH + tk * 1024 + h * 128 + seg), k1 = *(const v4u*)(KSH + tk * 1024 + h * 128 + seg + 8);
              const v4u v0 = *(const v4u*)(VSH + tk * 1024 + h * 128 + seg), v1 = *(const v4u*)(VSH + tk * 1024 + h * 128 + seg + 8);
#pragma unroll
              for (int i = 0; i < 4; ++i) { Ks[j * 132 + seg + 2 * i] = bflo(k0[i]); Ks[j * 132 + seg + 2 * i + 1] = bfhi(k0[i]); Ks[j * 132 + seg + 8 + 2 * i] = bflo(k1[i]); Ks[j * 132 + seg + 8 + 2 * i + 1] = bfhi(k1[i]);
                  Vs[j * 128 + seg + 2 * i] = bflo(v0[i]); Vs[j * 128 + seg + 2 * i + 1] = bfhi(v0[i]); Vs[j * 128 + seg + 8 + 2 * i] = bflo(v1[i]); Vs[j * 128 + seg + 8 + 2 * i + 1] = bfhi(v1[i]); } }
            __syncthreads();
            float s0[8], s1[8];
#pragma unroll
            for (int i = 0; i < 8; ++i) { const LAS float* kr = Ks + (p + 8 * i) * 132; float x0 = 0.f, x1 = 0.f;
#pragma unroll
                for (int d = 0; d < 64; d += 4) { const f32x4 ka = *(const LAS f32x4*)(kr + d), kb = *(const LAS f32x4*)(kr + 64 + d);
                    x0 += q0[d] * ka[0] + q0[d + 1] * ka[1] + q0[d + 2] * ka[2] + q0[d + 3] * ka[3];
                    x1 += q1[d] * kb[0] + q1[d + 1] * kb[1] + q1[d + 2] * kb[2] + q1[d + 3] * kb[3]; }
                s0[i] = x0; s1[i] = x1; }
            float mx0 = s0[0], mx1 = s1[0];
#pragma unroll
            for (int i = 1; i < 8; ++i) { mx0 = fmaxf(mx0, s0[i]); mx1 = fmaxf(mx1, s1[i]); }
#pragma unroll
            for (int off = 1; off <= 4; off <<= 1) { mx0 = fmaxf(mx0, __shfl_xor(mx0, off)); mx1 = fmaxf(mx1, __shfl_xor(mx1, off)); }
            const float mn0 = fmaxf(m0, mx0), mn1 = fmaxf(m1, mx1);
            const float al0 = __expf(m0 - mn0), al1 = __expf(m1 - mn1);
            float ps0 = 0.f, ps1 = 0.f;
#pragma unroll
            for (int i = 0; i < 8; ++i) { const float e0 = __expf(s0[i] - mn0), e1 = __expf(s1[i] - mn1); ps0 += e0; ps1 += e1;
                Ps[r * 65 + p + 8 * i] = e0; Ps[64 * 65 + r * 65 + p + 8 * i] = e1; }
#pragma unroll
            for (int off = 1; off <= 4; off <<= 1) { ps0 += __shfl_xor(ps0, off); ps1 += __shfl_xor(ps1, off); }
            l0 = l0 * al0 + ps0; l1 = l1 * al1 + ps1; m0 = mn0; m1 = mn1;
#pragma unroll
            for (int i = 0; i < 16; ++i) { O0[i] *= al0; O1[i] *= al1; }
            __syncthreads();
            for (int j = 0; j < 64; ++j) { const float pa = Ps[r * 65 + j], pb2 = Ps[64 * 65 + r * 65 + j]; const LAS float* vr = Vs + j * 128 + 16 * p;
#pragma unroll
                for (int c4 = 0; c4 < 16; c4 += 4) { const f32x4 vv = *(const LAS f32x4*)(vr + c4);
                    O0[c4] += pa * vv[0]; O0[c4 + 1] += pa * vv[1]; O0[c4 + 2] += pa * vv[2]; O0[c4 + 3] += pa * vv[3];
                    O1[c4] += pb2 * vv[0]; O1[c4 + 1] += pb2 * vv[1]; O1[c4 + 2] += pb2 * vv[2]; O1[c4 + 3] += pb2 * vv[3]; } }
        }
        const float i0 = 1.0f / l0, i1 = lam / l1; float o[16], ss = 0.f;
#pragma unroll
        for (int i = 0; i < 16; ++i) { o[i] = O0[i] * i0 - O1[i] * i1; ss += o[i] * o[i]; }
        ss += __shfl_xor(ss, 1); ss += __shfl_xor(ss, 2); ss += __shfl_xor(ss, 4);
        const float rn = rsqrtf(ss * (1.0f / 128.0f) + EPS) * (1.0f - LAMBDA_INIT);
        v4u w0, w1;
#pragma unroll
        for (int i = 0; i < 4; ++i) { w0[i] = pk2(o[2 * i] * rn * a->in[I_SUBLN][16 * p + 2 * i], o[2 * i + 1] * rn * a->in[I_SUBLN][16 * p + 2 * i + 1]);
            w1[i] = pk2(o[8 + 2 * i] * rn * a->in[I_SUBLN][16 * p + 8 + 2 * i], o[8 + 2 * i + 1] * rn * a->in[I_SUBLN][16 * p + 8 + 2 * i + 1]); }
        *(v4u*)(ON + tq * 1024 + h * 128 + 16 * p) = w0; *(v4u*)(ON + tq * 1024 + h * 128 + 16 * p + 8) = w1;
    }
}


constexpr int A_PK = 272, A_PV = 320, A_K = 0, A_V = 64 * A_PK, A_BUF = A_V + 64 * A_PV;
constexpr int A_X = 0;
DI void p12_attn(KA a, LAS unsigned char* lds, int tid, int lane, int wave, int vcu) {
    const bf16* QB = (const bf16*)(a->ws + WS_QB); const bf16* KSH = (const bf16*)(a->ws + WS_KSH); const bf16* VSH = (const bf16*)(a->ws + WS_VSH);
    bf16* ON = (bf16*)(a->ws + WS_ON);
    float lam;
    { const float s1 = wave_sum(a->in[I_LQ1][lane] * a->in[I_LK1][lane]), s2 = wave_sum(a->in[I_LQ2][lane] * a->in[I_LK2][lane]); lam = __expf(s1) - __expf(s2) + LAMBDA_INIT; }
    const int r32 = lane & 31, hh = lane >> 5, rg = wave >> 1, m = wave & 1;
    const int bh = vcu >> 2, jsel = vcu & 3, b = bh >> 3, h = bh & 7;
    const int srow0 = tid >> 4, scol = tid & 15;
    const float LOG2E = 1.4426950408889634f;
    if (bh >= 64) return;
#pragma unroll 1
    for (int ui = 0; ui < 4; ++ui) {
        const int qb = (ui == 0) ? jsel : (ui == 1) ? 7 - jsel : (ui == 2) ? 8 + jsel : 15 - jsel;
        const int ntile = 2 * qb + 2, myt = 2 * qb + 1 + (rg >> 1);
        const size_t tq = (size_t)b * SEQ + qb * 128 + rg * 32 + r32;
        bf16x8 Qf[4];
#pragma unroll
        for (int kk = 0; kk < 4; ++kk) Qf[kk] = *(const bf16x8*)(QB + tq * 1024 + h * 128 + 64 * m + 16 * kk + 8 * hh);
        f32x16 OT[4];
#pragma unroll
        for (int et = 0; et < 4; ++et)
#pragma unroll
            for (int i = 0; i < 16; ++i) OT[et][i] = 0.f;
        float mrun = -1.0e30f, lrun = 0.f;
        v4u rk[2], rv[2];
#define AT_LOAD(kt) do { const size_t tk = (size_t)b * SEQ + (kt) * 64; \
        _Pragma("unroll") for (int i = 0; i < 2; ++i) { const size_t go = (tk + srow0 + 32 * i) * 1024 + h * 128 + scol * 8; rk[i] = *(const v4u*)(KSH + go); rv[i] = *(const v4u*)(VSH + go); } } while (0)
#define AT_STORE(bufo) do { LAS unsigned char* B_ = lds + (bufo); \
        _Pragma("unroll") for (int i = 0; i < 2; ++i) { *(LAS v4u*)(B_ + A_K + (srow0 + 32 * i) * A_PK + scol * 16) = rk[i]; *(LAS v4u*)(B_ + A_V + (srow0 + 32 * i) * A_PV + scol * 16) = rv[i]; } } while (0)
        AT_LOAD(0); AT_STORE(0);
        __syncthreads();
        for (int kt = 0; kt < ntile; ++kt) {
            const LAS unsigned char* B = lds + (kt & 1) * A_BUF;
            if (kt + 1 < ntile) AT_LOAD(kt + 1);
            if (kt < myt) {
                f32x16 ST[2];
#pragma unroll
                for (int t = 0; t < 2; ++t) {
#pragma unroll
                    for (int i = 0; i < 16; ++i) ST[t][i] = 0.f;
                    const LAS unsigned char* kr = B + A_K + (32 * t + r32) * A_PK + (64 * m + 8 * hh) * 2;
#pragma unroll
                    for (int kk = 0; kk < 4; ++kk) ST[t] = __builtin_amdgcn_mfma_f32_32x32x16_bf16(*(const LAS bf16x8*)(kr + 32 * kk), Qf[kk], ST[t], 0, 0, 0);
                }
                float mx = ST[0][0];
#pragma unroll
                for (int t = 0; t < 2; ++t)
#pragma unroll
                    for (int i = 0; i < 16; ++i) mx = fmaxf(mx, ST[t][i]);
                mx = fmaxf(mx, __shfl_xor(mx, 32));
                const float mnew = fmaxf(mrun, mx * LOG2E);
                const float alpha = __builtin_amdgcn_exp2f(mrun - mnew);
                mrun = mnew;
                float ps = 0.f;
#pragma unroll
                for (int t = 0; t < 2; ++t)
#pragma unroll
                    for (int i = 0; i < 16; ++i) { const float pv = __builtin_amdgcn_exp2f(ST[t][i] * LOG2E - mnew); ST[t][i] = pv; ps += pv; }
                lrun = lrun * alpha + ps;
#pragma unroll
                for (int et = 0; et < 4; ++et)
#pragma unroll
                    for (int i = 0; i < 16; ++i) OT[et][i] *= alpha;
#pragma unroll
                for (int t = 0; t < 2; ++t)
#pragma unroll
                    for (int sp = 0; sp < 2; ++sp) {
                        v4u pw; pw.x = pg8::cvt_pk_bf16(ST[t][8 * sp], ST[t][8 * sp + 1]); pw.y = pg8::cvt_pk_bf16(ST[t][8 * sp + 2], ST[t][8 * sp + 3]);
                        pw.z = pg8::cvt_pk_bf16(ST[t][8 * sp + 4], ST[t][8 * sp + 5]); pw.w = pg8::cvt_pk_bf16(ST[t][8 * sp + 6], ST[t][8 * sp + 7]);
                        const bf16x8 pb = __builtin_bit_cast(bf16x8, pw);
                        const LAS unsigned char* vb = B + A_V + (32 * t + 16 * sp + 4 * hh + ((lane & 15) >> 2)) * A_PV + (16 * ((lane >> 4) & 1) + 4 * (lane & 3)) * 2;
#pragma unroll
                        for (int et = 0; et < 4; ++et) {
                            const s16x4 lo = lds_tr16_b64(vb + 64 * et), hi = lds_tr16_b64(vb + 64 * et + 8 * A_PV);
                            const bf16x8 va = __builtin_shufflevector(lo, hi, 0, 1, 2, 3, 4, 5, 6, 7);
                            OT[et] = __builtin_amdgcn_mfma_f32_32x32x16_bf16(va, pb, OT[et], 0, 0, 0);
                        }
                    }
            }
            if (kt + 1 < ntile) AT_STORE(((kt + 1) & 1) * A_BUF);
            __syncthreads();
        }
#undef AT_LOAD
#undef AT_STORE
        const float ltot = lrun + __shfl_xor(lrun, 32);
        const float sc = (m == 0) ? 1.0f / ltot : lam / ltot;
        LAS float* X = (LAS float*)(lds + A_X + rg * 16384);
        if (m == 1) {
#pragma unroll
            for (int et = 0; et < 4; ++et)
#pragma unroll
                for (int q4 = 0; q4 < 4; ++q4) { f32x4 v; v[0] = OT[et][4 * q4] * sc; v[1] = OT[et][4 * q4 + 1] * sc; v[2] = OT[et][4 * q4 + 2] * sc; v[3] = OT[et][4 * q4 + 3] * sc;
                    *(LAS f32x4*)(X + ((et * 4 + q4) * 64 + lane) * 4) = v; }
        }
        __syncthreads();
        if (m == 0) {
            float ss = 0.f;
#pragma unroll
            for (int et = 0; et < 4; ++et)
#pragma unroll
                for (int q4 = 0; q4 < 4; ++q4) { const f32x4 v = *(const LAS f32x4*)(X + ((et * 4 + q4) * 64 + lane) * 4);
#pragma unroll
                    for (int i = 0; i < 4; ++i) { const float o = OT[et][4 * q4 + i] * sc - v[i]; OT[et][4 * q4 + i] = o; ss += o * o; } }
            ss += __shfl_xor(ss, 32);
            const float rn = rsqrtf(ss * (1.0f / 128.0f) + EPS) * (1.0f - LAMBDA_INIT);
            asm volatile("s_waitcnt lgkmcnt(0)" ::: "memory");
            LAS unsigned char* T = (LAS unsigned char*)X;
#pragma unroll
            for (int et = 0; et < 4; ++et)
#pragma unroll
                for (int q4 = 0; q4 < 4; ++q4) { const int e0 = 32 * et + 8 * q4 + 4 * hh; const f32x4 sw = *(const f32x4*)(a->in[I_SUBLN] + e0);
                    v2u w; w.x = pk2(OT[et][4 * q4] * rn * sw[0], OT[et][4 * q4 + 1] * rn * sw[1]); w.y = pk2(OT[et][4 * q4 + 2] * rn * sw[2], OT[et][4 * q4 + 3] * rn * sw[3]);
                    *(LAS v2u*)(T + r32 * 272 + e0 * 2) = w; }
            asm volatile("s_waitcnt lgkmcnt(0)" ::: "memory");
            const size_t trow = (size_t)b * SEQ + qb * 128 + rg * 32;
#pragma unroll
            for (int i = 0; i < 8; ++i) { const int ch = lane + 64 * i, row = ch >> 4, c16 = ch & 15;
                *(v4u*)(ON + (trow + row) * 1024 + h * 128 + c16 * 8) = *(const LAS v4u*)(T + row * 272 + c16 * 16); }
        }
        __syncthreads();
    }
}

__global__ void __launch_bounds__(512, 2) fwd(Args a_by_value) {
    extern __shared__ __attribute__((aligned(16))) unsigned char lds_raw[];
    LAS unsigned char* lds = (LAS unsigned char*)lds_raw;
    const int tid = threadIdx.x;
    KA a = launder_args();
    const int G = gridDim.x; const int bx = blockIdx.x; const int vcu = (G % 8 == 0) ? (bx % 8) * (G / 8) + bx / 8 : bx;
    unsigned* ctl = (unsigned*)(a->ws + WS_CTL);
    for (int u = tid; u < (LDS_BYTES - LDSCTL_OFF) / 4; u += 512) ((LAS unsigned*)(lds + LDSCTL_OFF))[u] = 0u;
    __syncthreads();
    XcdBarrier bar; bar.bar = ctl + CW_BAR; bar.x = 0; bar.st = nullptr;
    const bool one_launch = (a->ph_hi - a->ph_lo) > 1;
    if (one_launch) bar = xcd_barrier_post(ctl + CW_BAR, (volatile LAS unsigned*)(lds + MISC_OFF) + 8);
    const int lo = a->ph_lo, hi = a->ph_hi;
#ifndef PHMASK
#define PHMASK 0xFFFFFFFFu
#endif
#define IN(k) ((((PHMASK) >> (k)) & 1u) && lo <= (k) && (k) < hi)
#define SEAM(k) do { if (IN(k) && IN((k) + 1)) xcd_barrier(bar); } while (0)
    unsigned char* ws = a->ws;

#define PH_IDS KA a = launder_args(); const int tid = fresh_tid(), lane = tid & 63, wave = __builtin_amdgcn_readfirstlane(tid >> 6); (void)tid; (void)lane; (void)wave
    if (IN(0)) { PH_IDS; p0_modvec(a, lds, tid, lane, wave); p0_convert(a, lds, lane, wave, vcu, G); }
    SEAM(0);
    if (IN(1)) { PH_IDS; p1_norm1(a, lds, tid, lane, wave, vcu, G); }
    SEAM(1);
    if (IN(2)) { PInProj P; P.A = (const char*)(ws + WS_XN); P.B = (const char*)(ws + WS_WIN); P.O = (bf16*)(ws + WS_PROJ); P.S.init(NTOK, 4096, G, bx);
        pg8::gemm_phase<PInProj, true>(lds, P); }
    SEAM(2);
#if DELTA_NAIVE
    if (IN(3)) { PH_IDS; p3_delta_naive(a, lds, tid, lane, wave); }
    SEAM(3);
    SEAM(4);
#else
    if (IN(3)) { PH_IDS; p3_chunk_local(a, lds, tid, lane, wave, vcu, G); }
    SEAM(3);
    if (IN(4)) { PH_IDS; p4_recurrence(a, lds, tid, lane, wave); }
    SEAM(4);
#endif
    if (IN(5)) { PH_IDS; p5_gated_norm(a, lane, wave, vcu, G); }
    SEAM(5);
    if (IN(6)) { POutProj P; P.A = (const char*)(ws + WS_ON); P.B = (const char*)(ws + WS_WOA); P.base = a->in[I_X]; P.out = a->out; P.gvec = (const float*)(ws + WS_MODV) + 2 * 1024; P.S.init(NTOK, 1024, G, bx);
        pg8::gemm_phase<POutProj, false>(lds, P); }
    SEAM(6);
    if (IN(7)) { PH_IDS; p7_router(a, lds, 0, tid, lane, wave, vcu, G); }
    SEAM(7);
    if (IN(8)) { PH_IDS; PMoe1 P; P.A = (const char*)(ws + WS_XN); P.B = (const char*)(ws + WS_WGU); P.HID = (bf16*)(ws + WS_HID); P.list = (const int*)(ws + WS_LIST);
        P.bg = a->in[I_BG]; P.bu = a->in[I_BU]; P.T = moe_tables(a, lds, 0, tid); P.G = G; P.vcu = vcu;
        pg8::gemm_phase<PMoe1, true>(lds, P); }
    SEAM(8);
    if (IN(9)) { PH_IDS; PMoe2 P; P.A = (const char*)(ws + WS_HID); P.B = (const char*)(ws + WS_WD); P.Y = (bf16*)(ws + WS_Y); P.bd = a->in[I_BDN]; P.T = moe_tables(a, lds, 0, tid); P.G = G; P.vcu = vcu;
        pg8::gemm_phase<PMoe2, true>(lds, P); }
    SEAM(9);
    if (IN(10)) { PH_IDS; p10_combine(a, lds, 0, tid, lane, wave, vcu, G); }
    SEAM(10);
    if (IN(11)) { PKVQ P; P.ws = ws; P.knorm = a->in[I_BKNORM]; P.qnorm = a->in[I_BQNORM]; P.S.init(NTOK, 3072, G, bx);
        pg8::gemm_phase<PKVQ, true>(lds, P); }
    SEAM(11);
#if ATTN_NAIVE
    if (IN(12)) { PH_IDS; p12_attn_naive(a, lds, tid, lane, wave); }
#else
    if (IN(12)) { PH_IDS; p12_attn(a, lds, tid, lane, wave, vcu); }
#endif
    SEAM(12);
    if (IN(13)) { POutProj P; P.A = (const char*)(ws + WS_ON); P.B = (const char*)(ws + WS_WOB); P.base = a->out; P.out = a->out; P.gvec = (const float*)(ws + WS_MODV) + 6144 + 2 * 1024; P.S.init(NTOK, 1024, G, bx);
        pg8::gemm_phase<POutProj, false>(lds, P); }
    SEAM(13);
    if (IN(14)) { PH_IDS; p7_router(a, lds, 1, tid, lane, wave, vcu, G); }
    SEAM(14);
    if (IN(15)) { PH_IDS; PMoe1 P; P.A = (const char*)(ws + WS_XN); P.B = (const char*)(ws + WS_WGU) + (size_t)32 * 2048 * 2048; P.HID = (bf16*)(ws + WS_HID); P.list = (const int*)(ws + WS_LIST);
        P.bg = a->in[I_BG] + 32 * 1024; P.bu = a->in[I_BU] + 32 * 1024; P.T = moe_tables(a, lds, 1, tid); P.G = G; P.vcu = vcu;
        pg8::gemm_phase<PMoe1, true>(lds, P); }
    SEAM(15);
    if (IN(16)) { PH_IDS; PMoe2 P; P.A = (const char*)(ws + WS_HID); P.B = (const char*)(ws + WS_WD) + (size_t)32 * 1024 * 2048; P.Y = (bf16*)(ws + WS_Y); P.bd = a->in[I_BDN] + 32 * 1024; P.T = moe_tables(a, lds, 1, tid); P.G = G; P.vcu = vcu;
        pg8::gemm_phase<PMoe2, true>(lds, P); }
    SEAM(16);
    if (IN(17)) { PH_IDS; p10_combine(a, lds, 1, tid, lane, wave, vcu, G); }
#undef IN
#undef SEAM
}

extern "C" void kernel_launch(void* const* d_in, const int* in_sizes, int n_in, void* d_out, int out_size, void* d_ws, size_t ws_size, hipStream_t stream) {
    static int grid = 0;
    if (grid == 0) {
        if (n_in != 31 || out_size != NTOK * D || ws_size < WS_END) { fprintf(stderr, "kernel_launch: unexpected shapes (n_in %d out %d ws %zu)\n", n_in, out_size, ws_size); grid = -1; return; }
        int dev = 0, cus = 0, per_cu = 0;
        if (hipGetDevice(&dev) != hipSuccess || hipDeviceGetAttribute(&cus, hipDeviceAttributeMultiprocessorCount, dev) != hipSuccess) { grid = -1; return; }
        if (hipFuncSetAttribute((const void*)fwd, hipFuncAttributeMaxDynamicSharedMemorySize, LDS_BYTES) != hipSuccess) { fprintf(stderr, "kernel_launch: hipFuncSetAttribute failed\n"); grid = -1; return; }
        if (hipOccupancyMaxActiveBlocksPerMultiprocessor(&per_cu, (const void*)fwd, 512, LDS_BYTES) != hipSuccess || per_cu < 1) fprintf(stderr, "kernel_launch: occupancy query says %d\n", per_cu);
        (void)hipGetLastError();
        grid = cus;
    }
    if (grid < 0) return;
    (void)hipMemsetAsync((char*)d_ws + WS_CTL, 0, CTL_ZERO_BYTES, stream);
    Args a{};
    for (int i = 0; i < 31; ++i) a.in[i] = (const float*)d_in[i];
    a.out = (float*)d_out; a.ws = (unsigned char*)d_ws;
#if MK_PER_PHASE
    for (int p = 0; p < NPHASE; ++p) {
        if (p == 4 && DELTA_NAIVE) continue;
        a.ph_lo = p; a.ph_hi = p + 1;
        hipLaunchKernelGGL(fwd, dim3(grid), dim3(512), LDS_BYTES, stream, a);
    }
#else
    a.ph_lo = 0; a.ph_hi = NPHASE;
    hipLaunchKernelGGL(fwd, dim3(grid), dim3(512), LDS_BYTES, stream, a);
#endif
}
```

```cpp
#include <hip/hip_runtime.h>
#include <cstdio>

#ifndef DELTA_NAIVE
#define DELTA_NAIVE 0
#endif
#ifndef ATTN_NAIVE
#define ATTN_NAIVE 0
#endif
#ifndef PROBE_PHASE
#define PROBE_PHASE -1
#endif
#ifndef MK_PER_PHASE
#define MK_PER_PHASE 0
#endif

#define DI __device__ __forceinline__
#define GAS __attribute__((address_space(1)))
#define LAS __attribute__((address_space(3)))
typedef unsigned short bf16;
typedef unsigned v4u __attribute__((ext_vector_type(4)));
typedef unsigned v2u __attribute__((ext_vector_type(2)));
typedef float f32x4 __attribute__((ext_vector_type(4)));
typedef float f32x2 __attribute__((ext_vector_type(2)));
typedef short bf16x8 __attribute__((ext_vector_type(8)));

constexpr int NB = 8, SEQ = 2048, D = 1024, NTOK = NB * SEQ;
constexpr int NEXP = 32;
constexpr int AIN = 4112;
constexpr float EPS = 1e-6f;
constexpr int MODW = 14336;
constexpr float LAMBDA_INIT = 0.35550906f;
constexpr int NPHASE = 18;

constexpr size_t MiB = 1u << 20;
constexpr size_t WS_CTL = 0, CTL_ZERO_BYTES = 1 * MiB;
constexpr size_t WS_MODV = 1 * MiB;
constexpr size_t WS_BETA = 2 * MiB;
constexpr size_t WS_GDEC = 2 * MiB + 512 * 1024;
constexpr size_t WS_SEL = 3 * MiB;
constexpr size_t WS_POS = 3 * MiB + 256 * 1024;
constexpr size_t WS_GATE = 3 * MiB + 512 * 1024;
constexpr size_t WS_LIST = 4 * MiB;
constexpr size_t WS_WIN = 8 * MiB;
constexpr size_t WS_WOA = 16 * MiB, WS_WKV = 18 * MiB, WS_WQ = 22 * MiB, WS_WOB = 24 * MiB;
constexpr size_t WS_WGU = 32 * MiB;
constexpr size_t WS_WD = 288 * MiB;
constexpr size_t WS_XN = 416 * MiB, WS_XKV = 448 * MiB;
constexpr size_t WS_PROJ = 480 * MiB;
constexpr size_t WS_HID = 480 * MiB;
constexpr size_t WS_Y = 624 * MiB;
constexpr size_t WS_OD = 768 * MiB, WS_KSH = 768 * MiB;
constexpr size_t WS_ON = 800 * MiB, WS_QB = 832 * MiB, WS_VSH = 864 * MiB;
constexpr size_t WS_GC = 6 * MiB;
constexpr size_t WS_EG = 6 * MiB + 512 * 1024, WS_EGL = 7 * MiB;
constexpr size_t WS_QN = 624 * MiB, WS_KN = 656 * MiB, WS_WW = 688 * MiB;
constexpr size_t WS_UUT = 720 * MiB;
constexpr size_t WS_QKM = 752 * MiB;
constexpr size_t WS_END = 896 * MiB;
constexpr int CW_TMO = 0, CW_CODE = 1, CW_BAR = 4096, CW_CNT = 8192;

constexpr int RING_BYTES = 131072;
constexpr int LDSCTL_OFF = 159744, MISC_OFF = LDSCTL_OFF + 320, TAB_OFF = LDSCTL_OFF + 1024;
constexpr int MOE_STAGE_OFF = 141312;
constexpr int LDS_BYTES = 163840;

#define RLX_AGENT __ATOMIC_RELAXED, __HIP_MEMORY_SCOPE_AGENT
DI unsigned f2bf(float f) { unsigned u = __builtin_bit_cast(unsigned, f); return (u + 0x7fffu + ((u >> 16) & 1u)) >> 16; }
DI unsigned pk2(float lo, float hi) { return f2bf(lo) | (f2bf(hi) << 16); }
DI float bf2f(unsigned h) { return __builtin_bit_cast(float, h << 16); }
DI float bflo(unsigned w) { return __builtin_bit_cast(float, w << 16); }
DI float bfhi(unsigned w) { return __builtin_bit_cast(float, w & 0xffff0000u); }
DI float silu_f(float x) { return x / (1.f + __expf(-x)); }
DI float sigmoid_f(float x) { return 1.f / (1.f + __expf(-x)); }
DI float softplus_f(float x) { return x > 20.f ? x : log1pf(__expf(x)); }
DI int fresh_tid() { int t = threadIdx.x; asm volatile("" : "+v"(t)); return t; }
DI float wave_sum(float v) {
#pragma unroll
    for (int o = 1; o < 64; o <<= 1) v += __shfl_xor(v, o);
    return v;
}
template <int OFF> DI void rs_step(float (&v)[64], int lane) {
    const bool up = (lane & OFF) != 0;
#pragma unroll
    for (int i = 0; i < OFF; ++i) { const float keep = up ? v[i + OFF] : v[i]; const float send = up ? v[i] : v[i + OFF]; v[i] = keep + __shfl_xor(send, OFF); }
}
DI float rs64(float (&v)[64], int lane) {
    rs_step<32>(v, lane); rs_step<16>(v, lane); rs_step<8>(v, lane); rs_step<4>(v, lane); rs_step<2>(v, lane); rs_step<1>(v, lane);
    return v[0];
}

#define XB_TMO      128
#define XB_XCNT(j)  (256  + 64 * (j))
#define XB_XSUB(j)  (1280 + 64 * (j))
#define XB_XGEN(j)  (2304 + 64 * (j))
#define XB_TOP      3328
#define XB_TOPGEN   3392
#define XCD_BAR_WORDS 3456
#define XB_SPIN_CAP (1u << 18)
DI unsigned xb_ld(unsigned* p)              { return __hip_atomic_load(p, __ATOMIC_RELAXED, __HIP_MEMORY_SCOPE_AGENT); }
DI unsigned xb_add(unsigned* p, unsigned v) { return __hip_atomic_fetch_add(p, v, __ATOMIC_RELAXED, __HIP_MEMORY_SCOPE_AGENT); }
DI unsigned xb_xcc_id() { return (unsigned)__builtin_amdgcn_s_getreg((3 << 11) | 20) & 0xFu; }
#define XB_SPIN(cond, bar) do { unsigned _sp = 0; while (cond) { __builtin_amdgcn_s_sleep(1); \
    if ((++_sp & 255u) == 0u) { if (xb_ld(&(bar)[XB_TMO])) break; if (_sp > XB_SPIN_CAP) { atomicAdd(&(bar)[XB_TMO], 1u); break; } } } } while (0)
struct XcdBarrier { unsigned* bar; unsigned x; volatile LAS unsigned* st; };
DI XcdBarrier xcd_barrier_post(unsigned* bar, volatile LAS unsigned* st) {
    XcdBarrier b; b.bar = bar; b.x = xb_xcc_id(); b.st = st;
    if (threadIdx.x == 0) (void)xb_add(&bar[XB_XCNT(b.x)], 1u);
    return b;
}
DI void xcd_barrier_complete(unsigned* bar, unsigned x, unsigned& nloc, unsigned& nx) {
    const unsigned G = gridDim.x * gridDim.y * gridDim.z;
    unsigned sum, cnt, mine, sp = 0u;
    for (;;) {
        sum = 0u; cnt = 0u; mine = 0u;
#pragma unroll
        for (unsigned j = 0; j < 16; ++j) { const unsigned c = xb_ld(&bar[XB_XCNT(j)]); sum += c; cnt += (c > 0u) ? 1u : 0u; mine = (j == x) ? c : mine; }
        if (sum == G) break;
        __builtin_amdgcn_s_sleep(1);
        if ((++sp & 255u) == 0u) { if (xb_ld(&bar[XB_TMO])) break; if (sp > XB_SPIN_CAP) { atomicAdd(&bar[XB_TMO], 1u); break; } }
    }
    nloc = mine > 0u ? mine : 1u; nx = cnt > 0u ? cnt : 1u;
}
DI void xcd_barrier(const XcdBarrier& b) {
    asm volatile("s_waitcnt vmcnt(0)" ::: "memory");
    __syncthreads();
    if (threadIdx.x == 0) {
        unsigned* bar = b.bar;
        __builtin_amdgcn_s_waitcnt(0);
        unsigned nloc = b.st[0], nx = b.st[1];
        if (nloc == 0u) { xcd_barrier_complete(bar, b.x, nloc, nx); b.st[0] = nloc; b.st[1] = nx; }
        const unsigned old = xb_add(&bar[XB_XSUB(b.x)], 1u);
        const unsigned gen = old / nloc;
        if (old + 1u == (gen + 1u) * nloc) {
            __builtin_amdgcn_fence(__ATOMIC_RELEASE, "agent");
            asm volatile("s_waitcnt vmcnt(0)" ::: "memory");
            const unsigned og = xb_add(&bar[XB_TOP], 1u);
            const unsigned tg = og / nx;
            if (og + 1u == (tg + 1u) * nx) xb_add(&bar[XB_TOPGEN], 1u);
            else XB_SPIN(xb_ld(&bar[XB_TOPGEN]) == tg, bar);
            __builtin_amdgcn_fence(__ATOMIC_ACQUIRE, "agent");
            xb_add(&bar[XB_XGEN(b.x)], 1u);
            asm volatile("s_waitcnt vmcnt(0)" ::: "memory");
        } else {
            XB_SPIN(xb_ld(&bar[XB_XGEN(b.x)]) == gen, bar);
            __builtin_amdgcn_fence(__ATOMIC_ACQUIRE, "agent");
            asm volatile("s_waitcnt vmcnt(0)" ::: "memory");
        }
    }
    __syncthreads();
}

namespace pg8 {
constexpr int BM = 256, BK = 64, HALF = 128, HTB = HALF * BK * 2, STAGE_BYTES = 8 * HTB, NXCD = 8, WGM = 8;
constexpr int KD = 1024, NT = KD / BK;
DI int lds_byte(int r, int c) { const int st = (r >> 4) * 2 + (c >> 5), rr = r & 15, cc = c & 31, ob = rr * 64 + cc * 2; return st * 1024 + (ob ^ (((ob >> 9) & 1) << 5)); }
DI void stage_rc(int b, int& R, int& C) { const int st = b / 1024, sb = b % 1024, swz = sb ^ (((sb >> 9) & 1) << 5); R = (st >> 1) * 16 + swz / 64; C = (st & 1) * 32 + (swz % 64) / 2; }
DI int perm32(int rho) { const int n = rho >> 4, i = rho & 15; return 8 * (i >> 2) + 4 * n + (i & 3); }
struct Unit { int pm, pn, ex, ord; };
struct StaticOrder {
    int nM, nN, nwg, G, c;
    DI void init(int M, int N, int G_, int c_) { nM = M / BM; nN = N / BM; nwg = nM * nN; G = G_; c = c_; }
    DI bool next(int i, Unit& u) const {
        const long L = (long)i * G + c; if (L >= nwg) return false;
        int wgid = (int)L; { const int q = nwg / NXCD, r = nwg % NXCD, xcd = wgid % NXCD, off = wgid / NXCD; wgid = (xcd < r ? xcd * (q + 1) : r * (q + 1) + (xcd - r) * q) + off; }
        const int nig = WGM * nN, gid = wgid / nig, fm = gid * WGM, gsz = (nM - fm) < WGM ? (nM - fm) : WGM;
        u.pm = fm + ((wgid % nig) % gsz); u.pn = (wgid % nig) / gsz; u.ex = 0; u.ord = i; return true;
    }
};
DI unsigned cvt_pk_bf16(float lo, float hi) { unsigned r; asm volatile("v_cvt_pk_bf16_f32 %0, %1, %2" : "=v"(r) : "v"(lo), "v"(hi)); return r; }

template <class P, bool ALIGN_EPI>
DI void gemm_phase(LAS unsigned char* lds, const P& pb) {
    const int tid = fresh_tid(), wid = __builtin_amdgcn_readfirstlane(tid >> 6), lane = tid & 63, wr = wid >> 2, wc = wid & 3, fr = lane & 15, fq = lane >> 4;
    constexpr int K = KD, nt = NT;
    int Rl[2], Cl[2]; unsigned voffB[2];
#pragma unroll
    for (int i = 0; i < 2; ++i) { int R, C; stage_rc(tid * 16 + i * 8192, R, C); const int Rb = P::PERM ? ((R & ~31) + perm32(R & 31)) : R;
        Rl[i] = R; Cl[i] = C; voffB[i] = (unsigned)(Rb * K + C) * 2u; }
    const size_t kstep = (size_t)(BK * 2);
    const size_t hstep = (size_t)HALF * K * 2;
    const unsigned ldsw = (unsigned)wid * 1024u;
    const int aoff = lds_byte(wr * 64 + fr, fq * 8), boff = lds_byte(wc * 32 + fr, fq * 8);
#define PG8_SA(b, h) (((b) * 2 + (h)) * HTB)
#define PG8_SB(b, h) ((4 + (b) * 2 + (h)) * HTB)
#define PG8_STAGE(bufoff, gbase, voff) do { _Pragma("unroll") for (int _i = 0; _i < 2; ++_i) \
        __builtin_amdgcn_global_load_lds((const unsigned*)((const char*)(gbase) + (voff)[_i]), (LAS unsigned*)(lds + (bufoff) + ldsw + _i * 8192), 16, 0, 0); } while (0)
#define PG8_STAGE_A(bufoff, h, vsel, kb) do { _Pragma("unroll") for (int _i = 0; _i < 2; ++_i) \
        __builtin_amdgcn_global_load_lds((const unsigned*)(abase + (size_t)(vsel)[h][_i] + (size_t)(kb)), (LAS unsigned*)(lds + (bufoff) + ldsw + _i * 8192), 16, 0, 0); } while (0)
#define PG8_LDA(dst, b, h) do { _Pragma("unroll") for (int m = 0; m < 4; ++m) _Pragma("unroll") for (int k = 0; k < 2; ++k) dst[m][k] = *(const LAS bf16x8*)(lds + PG8_SA(b, h) + aoff + m * 2048 + k * 1024); } while (0)
#define PG8_LDB(dst, b, h) do { _Pragma("unroll") for (int n = 0; n < 2; ++n) _Pragma("unroll") for (int k = 0; k < 2; ++k) dst[n][k] = *(const LAS bf16x8*)(lds + PG8_SB(b, h) + boff + n * 2048 + k * 1024); } while (0)
#define PG8_MMA(ai, bj, At, Bt) do { __builtin_amdgcn_s_setprio(1); _Pragma("unroll") for (int m = 0; m < 4; ++m) _Pragma("unroll") for (int n = 0; n < 2; ++n) _Pragma("unroll") for (int k = 0; k < 2; ++k) \
        acc[ai][bj][m][n] = __builtin_amdgcn_mfma_f32_16x16x32_bf16(Bt[n][k], At[m][k], acc[ai][bj][m][n], 0, 0, 0); __builtin_amdgcn_s_setprio(0); } while (0)
#define PG8_WAIT_V(n) asm volatile("s_waitcnt vmcnt(" #n ")" ::: "memory")
#define PG8_WAIT_L(n) asm volatile("s_waitcnt lgkmcnt(" #n ")" ::: "memory")
#define PG8_BAR __builtin_amdgcn_s_barrier()
#define PG8_SCHED __builtin_amdgcn_sched_barrier(0)
    Unit cur, nxt; int ui = 0;
    if (!pb.next(0, cur)) return;
    f32x4 acc[2][2][4][2];
#pragma unroll
    for (int a = 0; a < 2; ++a)
#pragma unroll
        for (int b = 0; b < 2; ++b)
#pragma unroll
            for (int m = 0; m < 4; ++m)
#pragma unroll
                for (int n = 0; n < 2; ++n) acc[a][b][m][n] = (f32x4){0.f, 0.f, 0.f, 0.f};
    bf16x8 At[4][2], B0[2][2], B1[2][2];
    const char* abase = pb.abase();
    unsigned vAc[2][2], vAn[2][2];
#pragma unroll
    for (int h = 0; h < 2; ++h)
#pragma unroll
        for (int i = 0; i < 2; ++i) { vAc[h][i] = pb.arow(cur, h * HALF + Rl[i]) + (unsigned)Cl[i] * 2u; vAn[h][i] = vAc[h][i]; }
    const char* cB = pb.bbase(cur);
    PG8_STAGE(PG8_SB(0, 0), cB, voffB); PG8_STAGE(PG8_SB(0, 1), cB + hstep, voffB); PG8_STAGE_A(PG8_SA(0, 0), 0, vAc, 0); PG8_STAGE_A(PG8_SA(0, 1), 1, vAc, 0);
    if (wr == 1) PG8_BAR;
    PG8_WAIT_V(2); PG8_BAR;
    PG8_STAGE(PG8_SB(1, 0), cB + kstep, voffB); PG8_STAGE_A(PG8_SA(1, 0), 0, vAc, kstep); PG8_STAGE(PG8_SB(1, 1), cB + hstep + kstep, voffB);
    PG8_WAIT_V(6); PG8_BAR;
    for (;;) {
        const bool has_next = pb.next(ui + 1, nxt);
        if (has_next) {
#pragma unroll
            for (int h = 0; h < 2; ++h)
#pragma unroll
                for (int i = 0; i < 2; ++i) vAn[h][i] = pb.arow(nxt, h * HALF + Rl[i]) + (unsigned)Cl[i] * 2u;
        } else {
#pragma unroll
            for (int h = 0; h < 2; ++h)
#pragma unroll
                for (int i = 0; i < 2; ++i) vAn[h][i] = vAc[h][i];
        }
        const char* nB = has_next ? pb.bbase(nxt) : cB;
        for (int t = 0; t < nt; t += 2) {
            const bool last = (t == nt - 2);
            const unsigned k1 = (unsigned)(t + 1) * (unsigned)kstep;
            const unsigned k2 = last ? 0u : (unsigned)(t + 2) * (unsigned)kstep;
            unsigned v2[2][2];
#pragma unroll
            for (int h = 0; h < 2; ++h)
#pragma unroll
                for (int i = 0; i < 2; ++i) v2[h][i] = last ? vAn[h][i] : vAc[h][i];
            const char* b2 = last ? nB : cB + (size_t)(t + 2) * kstep;
            const char* b3 = b2 + kstep;
            PG8_LDB(B0, 0, 0); PG8_LDB(B1, 0, 1); PG8_SCHED; PG8_LDA(At, 0, 0); PG8_STAGE_A(PG8_SA(1, 1), 1, vAc, k1);
            PG8_WAIT_V(8); PG8_WAIT_L(0); PG8_BAR; PG8_MMA(0, 0, At, B0); PG8_MMA(0, 1, At, B1); PG8_BAR; PG8_SCHED;
            PG8_LDA(At, 0, 1); PG8_STAGE(PG8_SB(0, 0), b2, voffB); PG8_STAGE(PG8_SB(0, 1), b2 + hstep, voffB); PG8_STAGE_A(PG8_SA(0, 0), 0, v2, k2);
            PG8_WAIT_V(8); PG8_WAIT_L(0); PG8_BAR; PG8_MMA(1, 0, At, B0); PG8_MMA(1, 1, At, B1); PG8_BAR; PG8_SCHED;
            PG8_LDB(B0, 1, 0); PG8_LDB(B1, 1, 1); PG8_SCHED; PG8_LDA(At, 1, 0); PG8_STAGE_A(PG8_SA(0, 1), 1, v2, k2);
            PG8_WAIT_V(8); PG8_WAIT_L(0); PG8_BAR; PG8_MMA(0, 0, At, B0); PG8_MMA(0, 1, At, B1); PG8_BAR; PG8_SCHED;
            PG8_LDA(At, 1, 1); PG8_STAGE(PG8_SB(1, 0), b3, voffB); PG8_STAGE(PG8_SB(1, 1), b3 + hstep, voffB); PG8_STAGE_A(PG8_SA(1, 0), 0, v2, k2 + (unsigned)kstep);
            PG8_WAIT_V(8); PG8_WAIT_L(0); PG8_BAR; PG8_MMA(1, 0, At, B0); PG8_MMA(1, 1, At, B1); PG8_BAR; PG8_SCHED;
        }
        if constexpr (ALIGN_EPI) { if (wr == 0) PG8_BAR; }
        pb.epi(acc, cur, wr, wc, fr, fq);
        if (!has_next) break;
#pragma unroll
        for (int a = 0; a < 2; ++a)
#pragma unroll
            for (int b = 0; b < 2; ++b)
#pragma unroll
                for (int m = 0; m < 4; ++m)
#pragma unroll
                    for (int n = 0; n < 2; ++n) acc[a][b][m][n] = (f32x4){0.f, 0.f, 0.f, 0.f};
        cur = nxt; cB = nB; ++ui;
#pragma unroll
        for (int h = 0; h < 2; ++h)
#pragma unroll
            for (int i = 0; i < 2; ++i) vAc[h][i] = vAn[h][i];
        if constexpr (ALIGN_EPI) { if (wr == 1) PG8_BAR; }
    }
    PG8_WAIT_V(0);
    if constexpr (!ALIGN_EPI) { if (wr == 0) PG8_BAR; }
    PG8_BAR;
#undef PG8_SA
#undef PG8_SB
#undef PG8_STAGE
#undef PG8_STAGE_A
#undef PG8_LDA
#undef PG8_LDB
#undef PG8_MMA
#undef PG8_WAIT_V
#undef PG8_WAIT_L
#undef PG8_BAR
#undef PG8_SCHED
}
}

struct Args { const float* in[31]; float* out; unsigned char* ws; int ph_lo, ph_hi; };
typedef const __attribute__((address_space(4))) Args* KA;
DI KA launder_args() { KA p = (KA)__builtin_amdgcn_kernarg_segment_ptr(); asm volatile("" : "+s"(p)); return p; }
enum { I_X = 0, I_C, I_ADAW, I_ADAB, I_AWIN, I_ACONV, I_ALOG, I_ADT, I_ANORM, I_AWOUT, I_KVADAW, I_KVADAB, I_BWK, I_BWV, I_BKNORM, I_BWQ, I_BQNORM,
       I_LQ1, I_LK1, I_LQ2, I_LK2, I_SUBLN, I_BWOUT, I_WR, I_BR, I_WG, I_BG, I_WU, I_BU, I_WDN, I_BDN };

using pg8::Unit;
typedef f32x4 AccT[2][2][4][2];

struct PInProj {
    static constexpr bool PERM = true;
    const char* A; const char* B; bf16* O; pg8::StaticOrder S;
    DI bool next(int i, Unit& u) const { return S.next(i, u); }
    DI const char* abase() const { return A; }
    DI unsigned arow(const Unit& u, int R) const { return (unsigned)(u.pm * 256 + R) * 2048u; }
    DI const char* bbase(const Unit& u) const { return B + (size_t)u.pn * (256 * 2048); }
    DI void epi(const AccT& acc, const Unit& u, int wr, int wc, int fr, int fq) const {
        const int row0 = u.pm * 256 + wr * 64 + fr, col0 = u.pn * 256 + wc * 32 + 8 * fq;
#pragma unroll
        for (int ai = 0; ai < 2; ++ai)
#pragma unroll
            for (int m = 0; m < 4; ++m) { bf16* rowp = O + (size_t)(row0 + ai * 128 + m * 16) * 4096 + col0;
#pragma unroll
                for (int bj = 0; bj < 2; ++bj) { const f32x4 v0 = acc[ai][bj][m][0], v1 = acc[ai][bj][m][1];
                    v4u w; w.x = pg8::cvt_pk_bf16(v0[0], v0[1]); w.y = pg8::cvt_pk_bf16(v0[2], v0[3]); w.z = pg8::cvt_pk_bf16(v1[0], v1[1]); w.w = pg8::cvt_pk_bf16(v1[2], v1[3]);
                    *(v4u*)(rowp + bj * 128) = w; } }
    }
};
struct POutProj {
    static constexpr bool PERM = false;
    const char* A; const char* B; const float* base; float* out; const float* gvec  ; pg8::StaticOrder S;
    DI bool next(int i, Unit& u) const { return S.next(i, u); }
    DI const char* abase() const { return A; }
    DI unsigned arow(const Unit& u, int R) const { return (unsigned)(u.pm * 256 + R) * 2048u; }
    DI const char* bbase(const Unit& u) const { return B + (size_t)u.pn * (256 * 2048); }
    DI void epi(const AccT& acc, const Unit& u, int wr, int wc, int fr, int fq) const {
        const int row0 = u.pm * 256 + wr * 64 + fr, col0 = u.pn * 256 + wc * 32 + 4 * fq;
        const float* gv = gvec + (size_t)((u.pm * 256) >> 11) * MODW + col0;
        f32x4 g[2][2];
#pragma unroll
        for (int bj = 0; bj < 2; ++bj)
#pragma unroll
            for (int n = 0; n < 2; ++n) g[bj][n] = *(const f32x4*)(gv + bj * 128 + n * 16);
#pragma unroll
        for (int ai = 0; ai < 2; ++ai)
#pragma unroll
            for (int m = 0; m < 4; ++m) { const size_t off = (size_t)(row0 + ai * 128 + m * 16) * 1024 + col0;
#pragma unroll
                for (int bj = 0; bj < 2; ++bj)
#pragma unroll
                    for (int n = 0; n < 2; ++n) { const f32x4 bs = *(const f32x4*)(base + off + bj * 128 + n * 16);
                        *(f32x4*)(out + off + bj * 128 + n * 16) = bs + g[bj][n] * acc[ai][bj][m][n]; } }
    }
};
constexpr int MOE_MAXU = 9;
struct MoeTab { const LAS int* cb; const LAS int* cnt; const LAS int* stage; int xq1, xq2, xq3, xq4, x, w, nw; };
#ifndef MOE_XCD_DEAL
#define MOE_XCD_DEAL 0
#endif
template <int NTILE> DI bool moe_decode(const MoeTab& T, int i, Unit& u) {
#if MOE_XCD_DEAL
    const int idx = i * T.nw + T.w, prl = idx / NTILE; if (prl >= T.xq4) return false;
    const int k = (prl >= T.xq1) + (prl >= T.xq2) + (prl >= T.xq3), base = k == 0 ? 0 : (k == 1 ? T.xq1 : (k == 2 ? T.xq2 : T.xq3));
    u.ex = T.x + 8 * k; u.pm = T.cb[u.ex] + (prl - base); u.pn = idx % NTILE; u.ord = i; return true;
#else
    const int idx = i * (T.nw * 8) + (T.x * T.nw + T.w), pr = idx / NTILE; if (pr >= T.cb[32]) return false;
    int e = 0; while (T.cb[e + 1] <= pr) ++e;
    u.ex = e; u.pm = pr; u.pn = idx % NTILE; u.ord = i; return true;
#endif
}
struct PMoe1 {
    static constexpr bool PERM = true;
    const char* A; const char* B  ; bf16* HID; const int* list; const float* bg; const float* bu; MoeTab T;
    DI bool next(int i, Unit& u) const { return moe_decode<8>(T, i, u); }
    DI const char* abase() const { return A; }
    DI int tok_global(const Unit& u, int R) const { const int pos = (u.pm - T.cb[u.ex]) * 256 + R; return pos < T.cnt[u.ex] ? list[u.ex * NTOK + pos] : 0; }
    DI unsigned arow(const Unit& u, int R) const { const int tok = u.ord < MOE_MAXU ? T.stage[u.ord * 512 + R] : tok_global(u, R); return (unsigned)tok * 2048u; }
    DI const char* bbase(const Unit& u) const { return B + ((size_t)u.ex * 2048 + (size_t)u.pn * 256) * 2048; }
    DI void stage_units(int tid) const {
        for (int i = 0; i < MOE_MAXU; ++i) { Unit u; if (!next(i, u)) break;
            if (tid < 256) ((LAS int*)T.stage)[i * 512 + tid] = tok_global(u, tid);
            else { const int t2 = tid - 256; ((LAS float*)T.stage)[i * 512 + 256 + t2] = (t2 < 128 ? bg : bu)[u.ex * 1024 + u.pn * 128 + (t2 & 127)]; } }
        __syncthreads();
    }
    DI void epi(const AccT& acc, const Unit& u, int wr, int wc, int fr, int fq) const {
        const int row0 = u.pm * 256 + wr * 64 + fr, hl = wc * 32 + 8 * fq, hc0 = u.pn * 128 + hl;
        f32x4 vg[2], vu[2];
        if (u.ord < MOE_MAXU) { const LAS float* sb = (const LAS float*)T.stage + u.ord * 512 + 256 + hl;
#pragma unroll
            for (int n = 0; n < 2; ++n) { vg[n] = *(const LAS f32x4*)(sb + 4 * n); vu[n] = *(const LAS f32x4*)(sb + 128 + 4 * n); } }
        else { const float* pbg = bg + u.ex * 1024 + hc0; const float* pbu = bu + u.ex * 1024 + hc0;
#pragma unroll
            for (int n = 0; n < 2; ++n) { vg[n] = *(const f32x4*)(pbg + 4 * n); vu[n] = *(const f32x4*)(pbu + 4 * n); } }
#pragma unroll
        for (int ai = 0; ai < 2; ++ai)
#pragma unroll
            for (int m = 0; m < 4; ++m) { bf16* rowp = HID + (size_t)(row0 + ai * 128 + m * 16) * 1024 + hc0; float r[8];
#pragma unroll
                for (int n = 0; n < 2; ++n)
#pragma unroll
                    for (int j = 0; j < 4; ++j) { float g = acc[ai][0][m][n][j] + vg[n][j], uu = acc[ai][1][m][n][j] + vu[n][j];
                        g = fminf(g, 7.0f); uu = fminf(fmaxf(uu, -7.0f), 7.0f);
                        r[4 * n + j] = g * sigmoid_f(1.702f * g) * (uu + 1.0f); }
                v4u w; w.x = pg8::cvt_pk_bf16(r[0], r[1]); w.y = pg8::cvt_pk_bf16(r[2], r[3]); w.z = pg8::cvt_pk_bf16(r[4], r[5]); w.w = pg8::cvt_pk_bf16(r[6], r[7]);
                *(v4u*)rowp = w; }
    }
};
struct PMoe2 {
    static constexpr bool PERM = true;
    const char* A  ; const char* B  ; bf16* Y; const float* bd; MoeTab T;
    DI bool next(int i, Unit& u) const { return moe_decode<4>(T, i, u); }
    DI const char* abase() const { return A; }
    DI unsigned arow(const Unit& u, int R) const { return (unsigned)(u.pm * 256 + R) * 2048u; }
    DI const char* bbase(const Unit& u) const { return B + ((size_t)u.ex * 1024 + (size_t)u.pn * 256) * 2048; }
    DI void stage_units(int tid) const {
        for (int i = 0; i < MOE_MAXU; ++i) { Unit u; if (!next(i, u)) break;
            if (tid >= 256) ((LAS float*)T.stage)[i * 512 + tid] = bd[u.ex * 1024 + u.pn * 256 + (tid - 256)]; }
        __syncthreads();
    }
    DI void epi(const AccT& acc, const Unit& u, int wr, int wc, int fr, int fq) const {
        const int row0 = u.pm * 256 + wr * 64 + fr, cl = wc * 32 + 8 * fq, col0 = u.pn * 256 + cl;
        f32x4 bv[2][2];
        if (u.ord < MOE_MAXU) { const LAS float* sb = (const LAS float*)T.stage + u.ord * 512 + 256 + cl;
#pragma unroll
            for (int bj = 0; bj < 2; ++bj)
#pragma unroll
                for (int n = 0; n < 2; ++n) bv[bj][n] = *(const LAS f32x4*)(sb + bj * 128 + 4 * n); }
        else { const float* pb = bd + u.ex * 1024 + col0;
#pragma unroll
            for (int bj = 0; bj < 2; ++bj)
#pragma unroll
                for (int n = 0; n < 2; ++n) bv[bj][n] = *(const f32x4*)(pb + bj * 128 + 4 * n); }
#pragma unroll
        for (int ai = 0; ai < 2; ++ai)
#pragma unroll
            for (int m = 0; m < 4; ++m) { bf16* rowp = Y + (size_t)(row0 + ai * 128 + m * 16) * 1024 + col0;
#pragma unroll
                for (int bj = 0; bj < 2; ++bj) { const f32x4 v0 = acc[ai][bj][m][0] + bv[bj][0], v1 = acc[ai][bj][m][1] + bv[bj][1];
                    v4u w; w.x = pg8::cvt_pk_bf16(v0[0], v0[1]); w.y = pg8::cvt_pk_bf16(v0[2], v0[3]); w.z = pg8::cvt_pk_bf16(v1[0], v1[1]); w.w = pg8::cvt_pk_bf16(v1[2], v1[3]);
                    *(v4u*)(rowp + bj * 128) = w; } }
    }
};
struct PKVQ {
    static constexpr bool PERM = true;
    unsigned char* ws; const float* knorm; const float* qnorm; pg8::StaticOrder S;
    DI bool next(int i, Unit& u) const { return S.next(i, u); }
    DI const char* abase() const { return (const char*)(ws + WS_XN); }
    DI unsigned arow(const Unit& u, int R) const { return (unsigned)(u.pm * 256 + R) * 2048u + (u.pn >= 8 ? 0u : (unsigned)(WS_XKV - WS_XN)); }
    DI const char* bbase(const Unit& u) const { const size_t off = u.pn >= 8 ? WS_WQ + (size_t)(u.pn - 8) * (256 * 2048) : WS_WKV + (size_t)u.pn * (256 * 2048); return (const char*)(ws + off); }
    DI void epi(const AccT& acc, const Unit& u, int wr, int wc, int fr, int fq) const {
        const int kind = u.pn >> 2;
        bf16* dst = (bf16*)(ws + (kind == 0 ? WS_KSH : (kind == 1 ? WS_VSH : WS_QB)));
        const float* kn = knorm; const float* qn = qnorm; const float* nw = kind == 2 ? qn : kn; const float sc = kind == 2 ? 0.125f : 1.0f;
        const int row0 = u.pm * 256 + wr * 64 + fr, colb = (u.pn & 3) * 256 + wc * 64 + 8 * fq;
        f32x4 w4[2][2];
#pragma unroll
        for (int bj = 0; bj < 2; ++bj)
#pragma unroll
            for (int n = 0; n < 2; ++n) { w4[bj][n] = *(const f32x4*)(nw + 32 * bj + 8 * fq + 4 * n) * sc; }
#pragma unroll
        for (int ai = 0; ai < 2; ++ai)
#pragma unroll
            for (int m = 0; m < 4; ++m) {
                float ss = 0.f;
#pragma unroll
                for (int bj = 0; bj < 2; ++bj)
#pragma unroll
                    for (int n = 0; n < 2; ++n) { const f32x4 x = acc[ai][bj][m][n]; ss += (x[0] * x[0] + x[1] * x[1]) + (x[2] * x[2] + x[3] * x[3]); }
                ss += __shfl_xor(ss, 16); ss += __shfl_xor(ss, 32);
                const float rn = kind == 1 ? 1.0f : rsqrtf(ss * (1.0f / 64.0f) + EPS);
                bf16* rowp = dst + (size_t)(row0 + ai * 128 + m * 16) * 1024 + colb;
#pragma unroll
                for (int bj = 0; bj < 2; ++bj) { f32x4 v0 = acc[ai][bj][m][0] * rn, v1 = acc[ai][bj][m][1] * rn;
                    if (kind != 1) { v0 = v0 * w4[bj][0]; v1 = v1 * w4[bj][1]; }
                    v4u w; w.x = pg8::cvt_pk_bf16(v0[0], v0[1]); w.y = pg8::cvt_pk_bf16(v0[2], v0[3]); w.z = pg8::cvt_pk_bf16(v1[0], v1[1]); w.w = pg8::cvt_pk_bf16(v1[2], v1[3]);
                    *(v4u*)(rowp + bj * 32) = w; } }
    }
};

DI void p0_modvec(KA a, LAS unsigned char* lds, int tid, int lane, int wave) {
    LAS float* cact = (LAS float*)lds;
    LAS float* red = (LAS float*)(lds + 32768);
    float* MODV = (float*)(a->ws + WS_MODV);
    if ((int)blockIdx.x >= 224) return;
    const float* c = a->in[I_C];
    for (int i = tid; i < 8192; i += 512) { const int b = i >> 10, k = i & 1023; cact[k * 8 + b] = silu_f(c[i]); }
    __syncthreads();
    for (int cg = blockIdx.x; cg < 224; cg += gridDim.x) {
        const int col0 = cg * 64; const float* W; int ld, col; const float* bp;
        if (col0 < 12288) { const int l = col0 / 6144; W = a->in[I_ADAW] + (size_t)l * 1024 * 6144; ld = 6144; col = col0 - l * 6144 + lane; bp = a->in[I_ADAB] + l * 6144 + col; }
        else { W = a->in[I_KVADAW]; ld = 2048; col = col0 - 12288 + lane; bp = a->in[I_KVADAB] + col; }
        float acc[8];
#pragma unroll
        for (int b = 0; b < 8; ++b) acc[b] = 0.f;
        const int k0 = wave * 128;
#pragma unroll 8
        for (int k = k0; k < k0 + 128; ++k) { const float w = W[(size_t)k * ld + col]; const f32x4 c0 = *(const LAS f32x4*)(cact + k * 8), c1 = *(const LAS f32x4*)(cact + k * 8 + 4);
            acc[0] += c0[0] * w; acc[1] += c0[1] * w; acc[2] += c0[2] * w; acc[3] += c0[3] * w; acc[4] += c1[0] * w; acc[5] += c1[1] * w; acc[6] += c1[2] * w; acc[7] += c1[3] * w; }
#pragma unroll
        for (int b = 0; b < 8; ++b) red[(wave * 8 + b) * 64 + lane] = acc[b];
        __syncthreads();
        float s = 0.f;
#pragma unroll
        for (int w = 0; w < 8; ++w) s += red[(w * 8 + wave) * 64 + lane];
        MODV[(size_t)wave * MODW + col0 + lane] = s + *bp;
        __syncthreads();
    }
}
constexpr int NQ_STATIC = 1280, NQ_L0 = NQ_STATIC + 24576, NQ_ATT = NQ_L0 + 1024, NQ_ALL = NQ_ATT + 24576;
DI int drow_rt(int mode, int n) {
    const int t = n & ~255, c = n & 255, wc = c >> 6, bj = (c >> 5) & 1, r = c & 31;
    const int m1 = t + 128 * bj + 32 * wc + r, m2 = (n >> 7) * 256 + (n & 127);
    return mode == 0 ? n : (mode == 1 ? m1 : (mode == 2 ? m2 : m2 + 128));
}
DI void convert_item(KA a, int q, LAS float* scr, int lane) {
    const float* W; int ldw = 1024; bf16* WT; int mode = 0, kb, nb; unsigned char* ws = a->ws;
    if (q < 1024) { W = a->in[I_AWIN]; ldw = AIN; WT = (bf16*)(ws + WS_WIN); kb = q >> 6; nb = q & 63; }
    else {
        int r = q - 1024; const int sub = r & 255; kb = sub >> 4; nb = sub & 15; r >>= 8;
        if (r == 0) { W = a->in[I_AWOUT]; WT = (bf16*)(ws + WS_WOA); }
        else if (r >= 97 && r <= 100) {
            if (r == 97) { W = a->in[I_BWK]; WT = (bf16*)(ws + WS_WKV); mode = 1; }
            else if (r == 98) { W = a->in[I_BWV]; WT = (bf16*)(ws + WS_WKV) + (size_t)1024 * 1024; mode = 1; }
            else if (r == 99) { W = a->in[I_BWQ]; WT = (bf16*)(ws + WS_WQ); mode = 1; }
            else { W = a->in[I_BWOUT]; WT = (bf16*)(ws + WS_WOB); }
        } else {
            const int mm = r <= 96 ? r - 1 : r - 5, le = mm / 3, which = mm - le * 3;
            if (which == 0) { W = a->in[I_WG] + (size_t)le * 1048576; WT = (bf16*)(ws + WS_WGU) + (size_t)le * 2097152; mode = 2; }
            else if (which == 1) { W = a->in[I_WU] + (size_t)le * 1048576; WT = (bf16*)(ws + WS_WGU) + (size_t)le * 2097152; mode = 3; }
            else { W = a->in[I_WDN] + (size_t)le * 1048576; WT = (bf16*)(ws + WS_WD) + (size_t)le * 1048576; }
        }
    }
    const int k0 = 64 * kb, n0 = 64 * nb;
    const int lr = lane >> 4, lc = (lane & 15) * 4;
#pragma unroll 4
    for (int i = 0; i < 16; ++i) { const int kk = 4 * i + lr; const f32x4 v = *(const f32x4*)(W + (size_t)(k0 + kk) * ldw + n0 + lc);
        LAS float* sp = scr + kk * 65 + lc; sp[0] = v[0]; sp[1] = v[1]; sp[2] = v[2]; sp[3] = v[3]; }
    asm volatile("s_waitcnt lgkmcnt(0)" ::: "memory");
    const int c = lane & 7;
#pragma unroll
    for (int j = 0; j < 8; ++j) { const int n = (lane >> 3) + 8 * j; const LAS float* sp = scr + (8 * c) * 65 + n;
        v4u o; o.x = pk2(sp[0 * 65], sp[1 * 65]); o.y = pk2(sp[2 * 65], sp[3 * 65]); o.z = pk2(sp[4 * 65], sp[5 * 65]); o.w = pk2(sp[6 * 65], sp[7 * 65]);
        *(v4u*)(WT + (size_t)drow_rt(mode, n0 + n) * 1024 + k0 + 8 * c) = o; }
    asm volatile("s_waitcnt lgkmcnt(0)" ::: "memory");
}
DI void p0_convert(KA a, LAS unsigned char* lds, int lane, int wave, int vcu, int G) {
    LAS float* scr = (LAS float*)(lds + wave * 16640);
    const int gw = vcu * 8 + wave, NGW = G * 8;
    const int nq = (a->ph_hi - a->ph_lo) > 1 ? NQ_STATIC : NQ_ALL;
    for (int it = gw; it < nq; it += NGW) convert_item(a, it, scr, lane);
}
constexpr int CW_QHEAD = 12288, CW_ARR = 12544;
DI void bg_convert(KA a, LAS unsigned char* lds, int need, int seam, int G) {
    const int tid = fresh_tid(), lane = tid & 63, wave = __builtin_amdgcn_readfirstlane(tid >> 6);
    unsigned* ctl = (unsigned*)(a->ws + WS_CTL); unsigned* qh = ctl + CW_QHEAD; unsigned* arr = ctl + CW_ARR + 16 * seam;
    LAS int* slot = (LAS int*)(lds + TAB_OFF + 2816);
    LAS float* scr = (LAS float*)(lds + wave * 16640);
    asm volatile("s_waitcnt vmcnt(0) lgkmcnt(0)" ::: "memory");
    __syncthreads();
    if (tid == 0) (void)__hip_atomic_fetch_add(arr, 1u, RLX_AGENT);
    constexpr int BATCH = 32;
    for (;;) {
        if (tid == 0) {
            int idx = (int)__hip_atomic_fetch_add(qh, (unsigned)BATCH, RLX_AGENT) + NQ_STATIC;
            if (idx >= need && idx < NQ_ALL && (int)__hip_atomic_load(arr, RLX_AGENT) >= G) {
                idx |= 0x40000000; }
            *slot = idx;
        }
        __syncthreads();
        const int raw = *slot;
        __syncthreads();
        const int idx = raw & 0x3fffffff;
        if (idx >= NQ_ALL) break;
#pragma unroll 1
        for (int j = 0; j < BATCH / 8; ++j) { const int q = idx + j * 8 + wave; if (q < NQ_ALL) convert_item(a, q, scr, lane); }
        if (raw & 0x40000000) break;
    }
}

DI void store_bf16_row(bf16* orow, int lane, const f32x4 (&v)[4]) {
    unsigned long long* o8 = (unsigned long long*)orow + lane;
#pragma unroll
    for (int j = 0; j < 4; ++j) o8[64 * j] = (unsigned long long)pk2(v[j][0], v[j][1]) | ((unsigned long long)pk2(v[j][2], v[j][3]) << 32);
}
DI void modulate_row(f32x4 (&v)[4], const float* shift, const float* scale, int lane) {
    float s = 0.f;
#pragma unroll
    for (int j = 0; j < 4; ++j) s += (v[j][0] * v[j][0] + v[j][1] * v[j][1]) + (v[j][2] * v[j][2] + v[j][3] * v[j][3]);
    const float rn = rsqrtf(wave_sum(s) * (1.0f / 1024.0f) + EPS);
#pragma unroll
    for (int j = 0; j < 4; ++j) { const f32x4 sh = *(const f32x4*)(shift + 4 * lane + 256 * j), sc = *(const f32x4*)(scale + 4 * lane + 256 * j); v[j] = v[j] * rn * (sc + 1.0f) + sh; }
}

DI void p1_norm1(KA a, LAS unsigned char* lds, int tid, int lane, int wave, int vcu, int G) {
    LAS float* wsm = (LAS float*)lds;
    const float* win = a->in[I_AWIN];
    for (int i = tid; i < 1024 * 16; i += 512) { const int k = i >> 4, jj = i & 15; const int l = (k >> 2) & 63, j = k >> 8, c = k & 3;
        wsm[(((j * 4 + c) * 4 + (jj >> 2)) * 64 + l) * 4 + (jj & 3)] = win[(size_t)k * AIN + 4096 + jj]; }
    __syncthreads();
    const float* MODV = (const float*)(a->ws + WS_MODV);
    bf16* XN = (bf16*)(a->ws + WS_XN);
    float* BETA = (float*)(a->ws + WS_BETA); float* GDEC = (float*)(a->ws + WS_GDEC);
    const int gw = vcu * 8 + wave, NGW = G * 8;
    for (int m0 = gw * 4; m0 < NTOK; m0 += NGW * 4) {
        const int b = m0 >> 11; const float* shift = MODV + (size_t)b * MODW; const float* scale = shift + 1024;
        float acc[64];
#pragma unroll
        for (int i = 0; i < 64; ++i) acc[i] = 0.f;
#pragma unroll
        for (int rp = 0; rp < 2; ++rp) {
            f32x4 v[2][4];
#pragma unroll
            for (int r2 = 0; r2 < 2; ++r2) { const int r = 2 * rp + r2; const f32x4* xr = (const f32x4*)(a->in[I_X] + (size_t)(m0 + r) * 1024) + lane;
#pragma unroll
                for (int j = 0; j < 4; ++j) v[r2][j] = xr[64 * j];
                modulate_row(v[r2], shift, scale, lane);
                store_bf16_row(XN + (size_t)(m0 + r) * 1024, lane, v[r2]); }
#pragma unroll
            for (int j = 0; j < 4; ++j)
#pragma unroll
                for (int c = 0; c < 4; ++c) {
#pragma unroll
                    for (int q = 0; q < 4; ++q) { const f32x4 w = *(const LAS f32x4*)(wsm + (((j * 4 + c) * 4 + q) * 64 + lane) * 4);
#pragma unroll
                        for (int r2 = 0; r2 < 2; ++r2) { const float xv = v[r2][j][c]; const int r = 2 * rp + r2;
                            acc[r * 16 + 4 * q + 0] += xv * w[0]; acc[r * 16 + 4 * q + 1] += xv * w[1]; acc[r * 16 + 4 * q + 2] += xv * w[2]; acc[r * 16 + 4 * q + 3] += xv * w[3]; } }
                    asm volatile("" ::: "memory"); __builtin_amdgcn_sched_barrier(0); }
        }
        const float val = rs64(acc, lane);
        const int tok = m0 + (lane >> 4), jj = lane & 15;
        if (jj < 8) BETA[tok * 8 + jj] = sigmoid_f(val);
        else { const int h = jj - 8; GDEC[tok * 8 + h] = -__expf(a->in[I_ALOG][h]) * softplus_f(val + a->in[I_ADT][h]); }
    }
}

DI void p3_delta_naive(KA a, LAS unsigned char* lds, int tid, int lane, int wave) {
    const bf16* PROJ = (const bf16*)(a->ws + WS_PROJ);
    const float* BETA = (const float*)(a->ws + WS_BETA); const float* GDEC = (const float*)(a->ws + WS_GDEC);
    bf16* OD = (bf16*)(a->ws + WS_OD);
    LAS float* buf = (LAS float*)lds;
    LAS float* gb = (LAS float*)(lds + 4096);
    for (int unit = blockIdx.x; unit < 64; unit += gridDim.x) {
        const int b = unit >> 3, h = unit & 7;
        __syncthreads();
        for (int s = tid; s < SEQ; s += 512) { gb[2 * s] = GDEC[(size_t)(b * SEQ + s) * 8 + h]; gb[2 * s + 1] = BETA[(size_t)(b * SEQ + s) * 8 + h]; }
        float S[64];
#pragma unroll
        for (int d = 0; d < 64; ++d) S[d] = 0.f;
        const int which = tid >> 7, c = tid & 127, col = (which < 3 ? which : 0) * 1024 + h * 128 + c;
        const float cw0 = a->in[I_ACONV][col], cw1 = a->in[I_ACONV][3072 + col], cw2 = a->in[I_ACONV][2 * 3072 + col], cw3 = a->in[I_ACONV][3 * 3072 + col];
        float p0 = 0.f, p1 = 0.f, p2 = 0.f;
        const bf16* pc = PROJ + (size_t)b * SEQ * 4096 + col;
        float pn = bf2f(pc[0]);
        const int se = wave * 32 + (lane & 31), dh = (lane >> 5) * 64;
        for (int s = 0; s < SEQ; ++s) {
            LAS float* cur = buf + (s & 1) * 512;
            const float pnow = pn;
            if (s + 1 < SEQ) pn = bf2f(pc[(size_t)(s + 1) * 4096]);
            const float val = silu_f(cw0 * p0 + cw1 * p1 + cw2 * p2 + cw3 * pnow); p0 = p1; p1 = p2; p2 = pnow;
            const float ss = wave_sum(val * val);
            if (tid < 384) cur[tid] = val;
            if (wave < 4 && lane == 0) cur[384 + wave] = ss;
            __syncthreads();
            if (wave < 4) {
                const float ssq = cur[384] + cur[385], ssk = cur[386] + cur[387];
                const float qsc = rsqrtf(ssq + EPS) * 0.08838834764831845f, ksc = rsqrtf(ssk + EPS);
                const float al = __expf(gb[2 * s]), bt = gb[2 * s + 1];
                float kv = 0.f;
#pragma unroll
                for (int d = 0; d < 64; d += 4) { const f32x4 kk = *(const LAS f32x4*)(cur + 128 + dh + d);
                    S[d] *= al; S[d + 1] *= al; S[d + 2] *= al; S[d + 3] *= al;
                    kv += S[d] * kk[0] + S[d + 1] * kk[1] + S[d + 2] * kk[2] + S[d + 3] * kk[3]; }
                kv += __shfl_xor(kv, 32);
                const float coef = ksc * bt * (cur[256 + se] - ksc * kv);
                float o = 0.f;
#pragma unroll
                for (int d = 0; d < 64; d += 4) { const f32x4 kk = *(const LAS f32x4*)(cur + 128 + dh + d), qq = *(const LAS f32x4*)(cur + dh + d);
                    S[d] += kk[0] * coef; S[d + 1] += kk[1] * coef; S[d + 2] += kk[2] * coef; S[d + 3] += kk[3] * coef;
                    o += S[d] * qq[0] + S[d + 1] * qq[1] + S[d + 2] * qq[2] + S[d + 3] * qq[3]; }
                o += __shfl_xor(o, 32);
                if (lane < 32) OD[(size_t)(b * SEQ + s) * 1024 + h * 128 + se] = (bf16)f2bf(o * qsc);
            }
        }
    }
}


typedef float f32x16 __attribute__((ext_vector_type(16)));
typedef short s16x4 __attribute__((ext_vector_type(4)));
DI s16x4 lds_tr16_b64(const LAS unsigned char* p) { typedef short v4i16_t __attribute__((ext_vector_type(4)));
    return __builtin_bit_cast(s16x4, __builtin_amdgcn_ds_read_tr16_b64_v4i16((LAS v4i16_t*)p)); }
DI bf16x8 cat8(v2u lo, v2u hi) { v4u t; t.x = lo.x; t.y = lo.y; t.z = hi.x; t.w = hi.y; return __builtin_bit_cast(bf16x8, t); }
DI bf16x8 pack8(const f32x4& a, const f32x4& b) { v4u t; t.x = pg8::cvt_pk_bf16(a[0], a[1]); t.y = pg8::cvt_pk_bf16(a[2], a[3]); t.z = pg8::cvt_pk_bf16(b[0], b[1]); t.w = pg8::cvt_pk_bf16(b[2], b[3]); return __builtin_bit_cast(bf16x8, t); }

constexpr int D3_P = 272;
constexpr int D3_LP = 68  , D3_PL = 144;
constexpr int D3_G = 0, D3_TH = 1024, D3_TL = 3072, D3_LH = 5120, D3_LL = D3_LH + 64 * D3_PL, D3_L = D3_LL + 64 * D3_PL, D3_Q = D3_L + 64 * D3_LP * 4, D3_K = D3_Q + 64 * D3_P, D3_V = D3_K + 64 * D3_P,
              D3_QK = D3_V + 64 * D3_P  , D3_W = D3_QK + 64 * D3_PL  ;
#define D3_BAR() do { asm volatile("s_waitcnt lgkmcnt(0)" ::: "memory"); __builtin_amdgcn_s_barrier(); asm volatile("" ::: "memory"); } while (0)
DI void p3_chunk_local(KA a, LAS unsigned char* lds, int tid, int lane, int wave, int vcu, int G) {
    const bf16* PROJ = (const bf16*)(a->ws + WS_PROJ);
    const float* BETA = (const float*)(a->ws + WS_BETA); const float* GDEC = (const float*)(a->ws + WS_GDEC);
    bf16* QN = (bf16*)(a->ws + WS_QN); bf16* KN = (bf16*)(a->ws + WS_KN); bf16* WW = (bf16*)(a->ws + WS_WW); bf16* UUT = (bf16*)(a->ws + WS_UUT); bf16* QKM = (bf16*)(a->ws + WS_QKM);
    float* GC = (float*)(a->ws + WS_GC);
    LAS float* Lm = (LAS float*)(lds + D3_L); LAS float* gcs = (LAS float*)(lds + D3_G); LAS float* bts = gcs + 64; LAS float* egs = gcs + 128;
    const float* cw = a->in[I_ACONV];
    const int r0 = 8 * wave;
    unsigned xr[3][11]; f32x2 cwr[3][4]; float pg = 0.f, pb_ = 0.f;
#define D3_PREFETCH(un) do { const int b_ = (un) >> 8, h_ = ((un) >> 5) & 7, n_ = (un) & 31; \
        _Pragma("unroll") for (int which = 0; which < 3; ++which) { const int col = which * 1024 + h_ * 128 + 2 * lane; \
            _Pragma("unroll") for (int j = 0; j < 4; ++j) cwr[which][j] = *(const f32x2*)(cw + j * 3072 + col); \
            _Pragma("unroll") for (int rr = 0; rr < 11; ++rr) { const int sl = n_ * 64 + r0 + rr - 3; unsigned v = 0u; if (sl >= 0) v = *(const unsigned*)(PROJ + ((size_t)b_ * SEQ + sl) * 4096 + col); xr[which][rr] = v; } } \
        if (wave == 0) { const size_t tq = (size_t)b_ * SEQ + n_ * 64 + lane; pg = GDEC[tq * 8 + h_]; pb_ = BETA[tq * 8 + h_]; } } while (0)
    if (vcu < 2048) D3_PREFETCH(vcu);
    for (int unit = vcu; unit < 2048; unit += G) {
        const int b = unit >> 8, h = (unit >> 5) & 7, n = unit & 31;
        const size_t t0 = (size_t)b * SEQ + n * 64;
#pragma unroll
        for (int which = 0; which < 3; ++which) {
#pragma unroll
            for (int i = 0; i < 8; ++i) {
                float o0 = cwr[which][0][0] * bflo(xr[which][i]) + cwr[which][1][0] * bflo(xr[which][i + 1]) + cwr[which][2][0] * bflo(xr[which][i + 2]) + cwr[which][3][0] * bflo(xr[which][i + 3]);
                float o1 = cwr[which][0][1] * bfhi(xr[which][i]) + cwr[which][1][1] * bfhi(xr[which][i + 1]) + cwr[which][2][1] * bfhi(xr[which][i + 2]) + cwr[which][3][1] * bfhi(xr[which][i + 3]);
                o0 = silu_f(o0); o1 = silu_f(o1);
                if (which < 2) { const float ss = wave_sum(o0 * o0 + o1 * o1); const float sc = rsqrtf(ss + EPS) * (which == 0 ? 0.08838834764831845f : 1.0f); o0 *= sc; o1 *= sc; }
                const unsigned pk = pk2(o0, o1);
                *(LAS unsigned*)(lds + D3_Q + which * (64 * D3_P) + (r0 + i) * D3_P + 4 * lane) = pk;
                if (which == 0) *(unsigned*)(QN + (t0 + r0 + i) * 1024 + h * 128 + 2 * lane) = pk;
                if (which == 1) *(unsigned*)(KN + (t0 + r0 + i) * 1024 + h * 128 + 2 * lane) = pk;
            }
        }
        if (wave == 0) {
            float g = pg; const float bt = pb_;
#pragma unroll
            for (int off = 1; off < 64; off <<= 1) { const float t = __shfl_up(g, off); if (lane >= off) g += t; }
            const float gl = __shfl(g, 63); const float eg_ = __expf(g);
            gcs[lane] = g; bts[lane] = bt; egs[lane] = eg_; GC[(t0 + lane) * 8 + h] = g;
            ((float*)(a->ws + WS_EG))[(t0 + lane) * 8 + h] = eg_; ((float*)(a->ws + WS_EGL))[(t0 + lane) * 8 + h] = __expf(gl - g);
        }
        if (unit + G < 2048) D3_PREFETCH(unit + G);
        D3_BAR();
        {
            const int kind = wave >> 2, ti = (wave >> 1) & 1, tj = wave & 1, r32 = lane & 31, hh = lane >> 5;
            f32x16 acc;
#pragma unroll
            for (int i = 0; i < 16; ++i) acc[i] = 0.f;
            if (ti >= tj) {
                const LAS unsigned char* Ab = lds + (kind ? D3_Q : D3_K) + (32 * ti + r32) * D3_P + 16 * hh;
                const LAS unsigned char* Bb = lds + D3_K + (32 * tj + r32) * D3_P + 16 * hh;
#pragma unroll
                for (int kk = 0; kk < 8; ++kk) { const bf16x8 av = *(const LAS bf16x8*)(Ab + 32 * kk), bv = *(const LAS bf16x8*)(Bb + 32 * kk);
                    acc = __builtin_amdgcn_mfma_f32_32x32x16_bf16(av, bv, acc, 0, 0, 0); }
            }
            const int j = 32 * tj + r32; const float gj = gcs[j];
#pragma unroll
            for (int reg = 0; reg < 16; ++reg) { const int i = 32 * ti + (reg & 3) + 8 * (reg >> 2) + 4 * hh;
                const float dec = (i >= j) ? __expf(gcs[i] - gj) : 0.f;
                if (kind == 0) { const float v = (i > j) ? bts[i] * acc[reg] * dec : 0.f; Lm[i * D3_LP + j] = v;
                    const unsigned nh = f2bf(-v); const unsigned nl = f2bf(-v - bf2f(nh));
                    *(LAS unsigned short*)(lds + D3_LH + i * D3_PL + 2 * j) = (unsigned short)nh; *(LAS unsigned short*)(lds + D3_LL + i * D3_PL + 2 * j) = (unsigned short)nl; }
                else *(LAS unsigned short*)(lds + D3_QK + i * D3_PL + 2 * j) = (unsigned short)f2bf(acc[reg] * dec); }
        }
        D3_BAR();
        if (wave == 0) {
            const int bb = lane >> 4, c = lane & 15;
            const LAS float* Lb = Lm + (16 * bb) * D3_LP + 16 * bb; asm volatile("" : "+v"(Lb));
            float t[16];
#pragma unroll
            for (int i = 0; i < 16; ++i) t[i] = 0.f;
#pragma unroll
            for (int i = 0; i < 16; ++i) {
                float r = (i == c) ? 1.f : 0.f;
#pragma unroll
                for (int jj = 0; jj < (i + 3) / 4; ++jj) { const f32x4 l4 = *(const LAS f32x4*)(Lb + i * D3_LP + 4 * jj);
                    r -= l4[0] * t[4 * jj]; r -= l4[1] * t[4 * jj + 1]; r -= l4[2] * t[4 * jj + 2]; r -= l4[3] * t[4 * jj + 3]; }
                t[i] = r;
                const unsigned th = f2bf(r); const unsigned tl = f2bf(r - bf2f(th));
                *(LAS unsigned short*)(lds + D3_TH + (bb * 16 + i) * 32 + 2 * c) = (unsigned short)th; *(LAS unsigned short*)(lds + D3_TL + (bb * 16 + i) * 32 + 2 * c) = (unsigned short)tl;
            }
        } else {
            const int ch = tid - 64;
            for (int c2 = ch; c2 < 512; c2 += 448) *(v4u*)(QKM + (size_t)unit * 4096 + c2 * 8) = *(const LAS v4u*)(lds + D3_QK + (c2 >> 3) * D3_PL + (c2 & 7) * 16);
        }
        D3_BAR();
        {
            const int g = lane >> 4, r16 = lane & 15;
#pragma unroll
            for (int q = 0; q < 2; ++q) {
                const int nt = 2 * wave + q, isw = nt >> 3, c = 16 * (nt & 7) + r16;
                const LAS unsigned char* src = lds + (isw ? D3_K : D3_V) + 2 * c + 4 * g * D3_P; asm volatile("" : "+v"(src));
                const LAS unsigned char* lhb = lds + D3_LH + r16 * D3_PL + 8 * g; asm volatile("" : "+v"(lhb));
                const LAS unsigned char* thb = lds + D3_TH + r16 * 32 + 8 * g; asm volatile("" : "+v"(thb));
                const LAS float* gb4 = bts + 4 * g; asm volatile("" : "+v"(gb4));
                s16x4 Xh[4], Xl[4];
#pragma unroll
                for (int b4 = 0; b4 < 4; ++b4) {
                    f32x4 acc;
#pragma unroll
                    for (int r = 0; r < 4; ++r) { float v = bf2f(*(const LAS unsigned short*)(src + (16 * b4 + r) * D3_P)) * gb4[16 * b4 + r]; const float ev = gb4[64 + 16 * b4 + r]; v *= isw ? ev : 1.0f; acc[r] = v; }
#pragma unroll
                    for (int bj = 0; bj < b4; ++bj) {
                        const s16x4 ah = *(const LAS s16x4*)(lhb + (16 * b4) * D3_PL + 32 * bj);
                        const s16x4 al = *(const LAS s16x4*)(lhb + (D3_LL - D3_LH) + (16 * b4) * D3_PL + 32 * bj);
                        acc = __builtin_amdgcn_mfma_f32_16x16x16bf16_1k(ah, Xh[bj], acc, 0, 0, 0);
                        acc = __builtin_amdgcn_mfma_f32_16x16x16bf16_1k(ah, Xl[bj], acc, 0, 0, 0);
                        acc = __builtin_amdgcn_mfma_f32_16x16x16bf16_1k(al, Xh[bj], acc, 0, 0, 0);
                    }
                    s16x4 ch, cl;
#pragma unroll
                    for (int r = 0; r < 4; ++r) { const unsigned hi = f2bf(acc[r]); ch[r] = (short)hi; cl[r] = (short)f2bf(acc[r] - bf2f(hi)); }
                    const s16x4 th = *(const LAS s16x4*)(thb + b4 * 512);
                    const s16x4 tl = *(const LAS s16x4*)(thb + (D3_TL - D3_TH) + b4 * 512);
                    f32x4 x = (f32x4){0.f, 0.f, 0.f, 0.f};
                    x = __builtin_amdgcn_mfma_f32_16x16x16bf16_1k(th, ch, x, 0, 0, 0);
                    x = __builtin_amdgcn_mfma_f32_16x16x16bf16_1k(th, cl, x, 0, 0, 0);
                    x = __builtin_amdgcn_mfma_f32_16x16x16bf16_1k(tl, ch, x, 0, 0, 0);
#pragma unroll
                    for (int r = 0; r < 4; ++r) { const unsigned hi = f2bf(x[r]); Xh[b4][r] = (short)hi; Xl[b4][r] = (short)f2bf(x[r] - bf2f(hi)); }
                }
                if (isw) {
#pragma unroll
                    for (int b4 = 0; b4 < 4; ++b4)
#pragma unroll
                        for (int r = 0; r < 4; ++r) *(LAS unsigned short*)(lds + D3_W + (16 * b4 + 4 * g + r) * D3_P + 2 * c) = (unsigned short)Xh[b4][r];
                } else {
#pragma unroll
                    for (int b4 = 0; b4 < 4; ++b4) *(s16x4*)(UUT + ((size_t)unit * 128 + c) * 64 + 16 * b4 + 4 * g) = Xh[b4];
                }
            }
        }
        D3_BAR();
#pragma unroll
        for (int i = 0; i < 2; ++i) { const int c2 = tid + 512 * i, row = c2 >> 4, cc = c2 & 15;
            *(v4u*)(WW + (t0 + row) * 1024 + h * 128 + cc * 8) = *(const LAS v4u*)(lds + D3_W + row * D3_P + cc * 16); }
    }
#undef D3_PREFETCH
}

constexpr int D4_PW = 272, D4_PK = 288, D4_PQK = 144, D4_PU = 144;
constexpr int D4_W = 0, D4_Q = 64 * D4_PW, D4_K = 2 * 64 * D4_PW, D4_QK = D4_K + 64 * D4_PK, D4_U = D4_QK + 64 * D4_PQK, D4_G = D4_U + 64 * D4_PU, D4_BUF = D4_G + 512;
constexpr int D4_O = 2 * D4_BUF;
#define D4_BAR() do { asm volatile("s_waitcnt lgkmcnt(0)" ::: "memory"); __builtin_amdgcn_s_barrier(); asm volatile("" ::: "memory"); } while (0)
DI void p4_recurrence(KA a, LAS unsigned char* lds, int tid, int lane, int wave) {
    const int bx = blockIdx.x; if ((bx >> 3) >= 16) return;
    const int slot = bx >> 3, bh = (bx & 7) * 8 + (slot >> 1), eh = slot & 1, b = bh >> 3, h = bh & 7;
    const bf16* QN = (const bf16*)(a->ws + WS_QN); const bf16* KN = (const bf16*)(a->ws + WS_KN); const bf16* WW = (const bf16*)(a->ws + WS_WW);
    const bf16* UUT = (const bf16*)(a->ws + WS_UUT); const bf16* QKM = (const bf16*)(a->ws + WS_QKM);
    const float* EG = (const float*)(a->ws + WS_EG); const float* EGL = (const float*)(a->ws + WS_EGL);
    bf16* OD = (bf16*)(a->ws + WS_OD);
    if (wave >= 4) {
        const int lt = tid - 256;
        struct Regs { v4u rw[4], rq[4], rk[4], rqk[2], ruu[2]; float rg; };
        Regs RA, RB; RA.rg = 0.f; RB.rg = 0.f;
#define D4_LOAD(R, nn) do { const size_t tt = (size_t)b * SEQ + (nn) * 64; const int un = bh * 32 + (nn); \
        _Pragma("unroll") for (int i = 0; i < 4; ++i) { const int c = lt + 256 * i; const size_t go = (tt + (c >> 4)) * 1024 + h * 128 + (c & 15) * 8; \
            R.rw[i] = *(const v4u*)(WW + go); R.rq[i] = *(const v4u*)(QN + go); R.rk[i] = *(const v4u*)(KN + go); } \
        _Pragma("unroll") for (int i = 0; i < 2; ++i) { const int c = lt + 256 * i; R.rqk[i] = *(const v4u*)(QKM + (size_t)un * 4096 + c * 8); \
            R.ruu[i] = *(const v4u*)(UUT + ((size_t)un * 128 + 64 * eh) * 64 + c * 8); } \
        R.rg = (lt < 64 ? EG : EGL)[(tt + (lt & 63)) * 8 + h]; } while (0)
#define D4_STORE(R, bufo) do { LAS unsigned char* B_ = lds + (bufo); \
        _Pragma("unroll") for (int i = 0; i < 4; ++i) { const int c = lt + 256 * i, row = c >> 4, cc = c & 15; \
            *(LAS v4u*)(B_ + D4_W + row * D4_PW + cc * 16) = R.rw[i]; *(LAS v4u*)(B_ + D4_Q + row * D4_PW + cc * 16) = R.rq[i]; *(LAS v4u*)(B_ + D4_K + row * D4_PK + cc * 16) = R.rk[i]; } \
        _Pragma("unroll") for (int i = 0; i < 2; ++i) { const int c = lt + 256 * i, row = c >> 3, cc = c & 7; \
            *(LAS v4u*)(B_ + D4_QK + row * D4_PQK + cc * 16) = R.rqk[i]; *(LAS v4u*)(B_ + D4_U + row * D4_PU + cc * 16) = R.ruu[i]; } \
        if (lt < 128) *(LAS float*)(B_ + D4_G + 4 * lt) = R.rg; } while (0)
        D4_LOAD(RA, 0); D4_STORE(RA, 0); D4_LOAD(RA, 1); D4_LOAD(RB, 2);
        D4_BAR();
        for (int n = 0; n < 32; n += 2) {
            asm volatile("s_waitcnt vmcnt(17)" ::: "memory");
            D4_STORE(RA, D4_BUF); if (n + 3 < 32) D4_LOAD(RA, n + 3);
            D4_BAR();
            if (n + 2 < 32) { if (n + 3 < 32) asm volatile("s_waitcnt vmcnt(17)" ::: "memory"); else asm volatile("s_waitcnt vmcnt(0)" ::: "memory");
                D4_STORE(RB, 0); if (n + 4 < 32) D4_LOAD(RB, n + 4); }
            D4_BAR();
        }
#undef D4_LOAD
#undef D4_STORE
        return;
    }
    const int g = lane >> 4, r16 = lane & 15;
    f32x4 S[8];
#pragma unroll
    for (int dt = 0; dt < 8; ++dt) S[dt] = (f32x4){0.f, 0.f, 0.f, 0.f};
    LAS unsigned char* Ost = lds + D4_O + wave * 2048;
    D4_BAR();
    for (int n = 0; n < 32; ++n) {
        const LAS unsigned char* B = lds + (n & 1) * D4_BUF;
        const LAS float* egs = (const LAS float*)(B + D4_G); const LAS float* els = egs + 64;
        const float egl = egs[63];
        bf16x8 Sb[4];
#pragma unroll
        for (int s = 0; s < 4; ++s) Sb[s] = pack8(S[2 * s], S[2 * s + 1]);
        f32x4 Vn[4], O[4];
        const LAS unsigned char* wb_ = B + D4_W + r16 * D4_PW + 8 * g;
        const LAS unsigned char* qb_ = B + D4_Q + r16 * D4_PW + 8 * g;
        const LAS unsigned char* kb_ = B + D4_QK + r16 * D4_PQK + 8 * g;
        const LAS unsigned char* ub_ = B + D4_U + (16 * wave + r16) * D4_PU + 8 * g;
        const LAS unsigned char* tb_ = B + D4_K + (4 * g + (r16 >> 2)) * D4_PK + 8 * (r16 & 3);
        bf16x8 fa[2][4], fq[2][4]; v2u uu[4]; f32x4 egv[4], elv[4];
#define D4_LDA(slot, mt) do { _Pragma("unroll") for (int s = 0; s < 4; ++s) { \
            fa[slot][s] = cat8(*(const LAS v2u*)(wb_ + (16 * (mt)) * D4_PW + 64 * s), *(const LAS v2u*)(wb_ + (16 * (mt)) * D4_PW + 64 * s + 32)); \
            fq[slot][s] = cat8(*(const LAS v2u*)(qb_ + (16 * (mt)) * D4_PW + 64 * s), *(const LAS v2u*)(qb_ + (16 * (mt)) * D4_PW + 64 * s + 32)); } } while (0)
#pragma unroll
        for (int mt = 0; mt < 4; ++mt) { uu[mt] = *(const LAS v2u*)(ub_ + 32 * mt); egv[mt] = *(const LAS f32x4*)(egs + 16 * mt + 4 * g); elv[mt] = *(const LAS f32x4*)(els + 16 * mt + 4 * g); }
        D4_LDA(0, 0); D4_LDA(1, 1);
        bf16x8 fk[4][2];
#pragma unroll
        for (int mt = 0; mt < 4; ++mt) {
            f32x4 av; av[0] = -bflo(uu[mt].x); av[1] = -bfhi(uu[mt].x); av[2] = -bflo(uu[mt].y); av[3] = -bfhi(uu[mt].y);
            f32x4 ao = (f32x4){0.f, 0.f, 0.f, 0.f};
#pragma unroll
            for (int s = 0; s < 4; ++s) {
                av = __builtin_amdgcn_mfma_f32_16x16x32_bf16(fa[mt & 1][s], Sb[s], av, 0, 0, 0);
                ao = __builtin_amdgcn_mfma_f32_16x16x32_bf16(fq[mt & 1][s], Sb[s], ao, 0, 0, 0);
            }
            if (mt + 2 < 4) D4_LDA(mt & 1, mt + 2);
            else {
#pragma unroll
                for (int m2 = 0; m2 < 2; ++m2)
#pragma unroll
                    for (int s2 = 0; s2 < 2; ++s2) { const int mm = 2 * (mt - 2) + m2;
                        fk[mm][s2] = cat8(*(const LAS v2u*)(kb_ + (16 * mm) * D4_PQK + 64 * s2), *(const LAS v2u*)(kb_ + (16 * mm) * D4_PQK + 64 * s2 + 32)); }
            }
            Vn[mt] = -av;
            O[mt] = ao * egv[mt];
        }
#undef D4_LDA
        bf16x8 ft[8][2];
#define D4_LDT(dt) do { _Pragma("unroll") for (int s2 = 0; s2 < 2; ++s2) { const s16x4 lo = lds_tr16_b64(tb_ + (32 * s2) * D4_PK + 32 * (dt)), hi = lds_tr16_b64(tb_ + (32 * s2 + 16) * D4_PK + 32 * (dt)); \
            ft[dt][s2] = __builtin_shufflevector(lo, hi, 0, 1, 2, 3, 4, 5, 6, 7); } } while (0)
        D4_LDT(0); D4_LDT(1); D4_LDT(2); D4_LDT(3);
        bf16x8 Vb[2];
#pragma unroll
        for (int s2 = 0; s2 < 2; ++s2) Vb[s2] = pack8(Vn[2 * s2], Vn[2 * s2 + 1]);
#pragma unroll
        for (int mt = 0; mt < 4; ++mt)
#pragma unroll
            for (int s2 = 0; s2 < 2; ++s2) O[mt] = __builtin_amdgcn_mfma_f32_16x16x32_bf16(fk[mt][s2], Vb[s2], O[mt], 0, 0, 0);
        D4_LDT(4); D4_LDT(5); D4_LDT(6); D4_LDT(7);
#undef D4_LDT
#pragma unroll
        for (int mt = 0; mt < 4; ++mt)
#pragma unroll
            for (int r = 0; r < 4; ++r) *(LAS unsigned short*)(Ost + (16 * mt + 4 * g + r) * 32 + 2 * r16) = (unsigned short)f2bf(O[mt][r]);
#pragma unroll
        for (int mt = 0; mt < 4; ++mt) Vn[mt] = Vn[mt] * elv[mt];
#pragma unroll
        for (int s2 = 0; s2 < 2; ++s2) Vb[s2] = pack8(Vn[2 * s2], Vn[2 * s2 + 1]);
#pragma unroll
        for (int dt = 0; dt < 8; ++dt) {
            f32x4 acc = S[dt] * egl;
#pragma unroll
            for (int s2 = 0; s2 < 2; ++s2) acc = __builtin_amdgcn_mfma_f32_16x16x32_bf16(ft[dt][s2], Vb[s2], acc, 0, 0, 0);
            S[dt] = acc;
        }
        { asm volatile("s_waitcnt lgkmcnt(0)" ::: "memory");
          const v4u o0 = *(const LAS v4u*)(Ost + lane * 32), o1 = *(const LAS v4u*)(Ost + lane * 32 + 16);
          bf16* op = OD + ((size_t)b * SEQ + n * 64 + lane) * 1024 + h * 128 + 64 * eh + 16 * wave;
          *(v4u*)op = o0; *(v4u*)(op + 8) = o1; }
        D4_BAR();
    }
}

DI void p5_gated_norm(KA a, int lane, int wave, int vcu, int G) {
    const bf16* OD = (const bf16*)(a->ws + WS_OD); const bf16* PROJ = (const bf16*)(a->ws + WS_PROJ); bf16* ON = (bf16*)(a->ws + WS_ON);
    const int gw = vcu * 8 + wave, NGW = G * 8;
    float nw[16];
#pragma unroll
    for (int i = 0; i < 16; ++i) nw[i] = a->in[I_ANORM][(16 * lane + i) & 127];
    for (int m = gw; m < NTOK; m += NGW) {
        const v4u o0 = *(const v4u*)(OD + (size_t)m * 1024 + 16 * lane), o1 = *(const v4u*)(OD + (size_t)m * 1024 + 16 * lane + 8);
        const v4u z0 = *(const v4u*)(PROJ + (size_t)m * 4096 + 3072 + 16 * lane), z1 = *(const v4u*)(PROJ + (size_t)m * 4096 + 3072 + 16 * lane + 8);
        float o[16], z[16];
#pragma unroll
        for (int i = 0; i < 4; ++i) { o[2 * i] = bflo(o0[i]); o[2 * i + 1] = bfhi(o0[i]); o[8 + 2 * i] = bflo(o1[i]); o[8 + 2 * i + 1] = bfhi(o1[i]);
            z[2 * i] = bflo(z0[i]); z[2 * i + 1] = bfhi(z0[i]); z[8 + 2 * i] = bflo(z1[i]); z[8 + 2 * i + 1] = bfhi(z1[i]); }
        float ss = 0.f;
#pragma unroll
        for (int i = 0; i < 16; ++i) ss += o[i] * o[i];
        ss += __shfl_xor(ss, 1); ss += __shfl_xor(ss, 2); ss += __shfl_xor(ss, 4);
        const float rn = rsqrtf(ss * (1.0f / 128.0f) + EPS);
        float r[16];
#pragma unroll
        for (int i = 0; i < 16; ++i) r[i] = o[i] * rn * nw[i] * silu_f(z[i]);
        v4u w0, w1;
#pragma unroll
        for (int i = 0; i < 4; ++i) { w0[i] = pk2(r[2 * i], r[2 * i + 1]); w1[i] = pk2(r[8 + 2 * i], r[8 + 2 * i + 1]); }
        *(v4u*)(ON + (size_t)m * 1024 + 16 * lane) = w0; *(v4u*)(ON + (size_t)m * 1024 + 16 * lane + 8) = w1;
    }
}

DI void p7_router(KA a, LAS unsigned char* lds, int layer, int tid, int lane, int wave, int vcu, int G) {
    LAS float* wr_l = (LAS float*)lds;
    LAS int* lcnt = (LAS int*)(lds + TAB_OFF);
    LAS int* lbase = lcnt + 32;
    LAS int* tsel = (LAS int*)(lds + TAB_OFF + 512);
    LAS float* tgate = (LAS float*)(lds + TAB_OFF + 512 + 1024);
    const float* wrt = a->in[I_WR] + (size_t)layer * 1024 * 32;
    for (int i = tid; i < 1024 * 32; i += 512) { const int k = i >> 5, e = i & 31; const int l = (k >> 2) & 63, j = k >> 8, c = k & 3;
        wr_l[(((j * 4 + c) * 8 + (e >> 2)) * 64 + l) * 4 + (e & 3)] = wrt[i]; }
    if (tid < 32) lcnt[tid] = 0;
    __syncthreads();
    const float* MODV = (const float*)(a->ws + WS_MODV);
    bf16* XN = (bf16*)(a->ws + WS_XN);
    const float* hbuf = a->out;
    int* SEL = (int*)(a->ws + WS_SEL); int* POS = (int*)(a->ws + WS_POS); float* GATE = (float*)(a->ws + WS_GATE); int* LIST = (int*)(a->ws + WS_LIST);
    unsigned* gcnt = (unsigned*)(a->ws + WS_CTL) + CW_CNT + layer * 32 * 16;
    const float bias = a->in[I_BR][layer * 32 + (lane & 31)];
    const int nrep7 = (PROBE_PHASE == 107 && layer == 0) ? 2 : 1;
#pragma unroll 1
    for (int rep = 0; rep < nrep7; ++rep)
    for (int grp = vcu; grp < NTOK / 64; grp += G) {
        const int t0 = grp * 64 + wave * 8;
#pragma unroll 1
        for (int pr = 0; pr < 4; ++pr) {
            const int m0 = t0 + 2 * pr; const int b = m0 >> 11;
            const float* shift = MODV + (size_t)b * MODW + layer * 6144 + 3072; const float* scale = shift + 1024;
            float acc[64];
#pragma unroll
            for (int i = 0; i < 64; ++i) acc[i] = 0.f;
#pragma unroll
            for (int r = 0; r < 2; ++r) {
                f32x4 v[4]; const f32x4* xr = (const f32x4*)(hbuf + (size_t)(m0 + r) * 1024) + lane;
#pragma unroll
                for (int j = 0; j < 4; ++j) v[j] = xr[64 * j];
                modulate_row(v, shift, scale, lane);
                store_bf16_row(XN + (size_t)(m0 + r) * 1024, lane, v);
#pragma unroll
                for (int j = 0; j < 4; ++j)
#pragma unroll
                    for (int c = 0; c < 4; ++c)
                    { _Pragma("unroll") for (int q = 0; q < 8; ++q) { const f32x4 w = *(const LAS f32x4*)(wr_l + (((j * 4 + c) * 8 + q) * 64 + lane) * 4); const float xv = v[j][c];
                            acc[r * 32 + 4 * q + 0] += xv * w[0]; acc[r * 32 + 4 * q + 1] += xv * w[1]; acc[r * 32 + 4 * q + 2] += xv * w[2]; acc[r * 32 + 4 * q + 3] += xv * w[3]; }
                      __builtin_amdgcn_sched_barrier(0); }
            }
            float val = rs64(acc, lane) + bias;
            const int e = lane & 31; const int tl = wave * 8 + 2 * pr + (lane >> 5);
            float topv[4]; int topi[4];
#pragma unroll
            for (int k = 0; k < 4; ++k) {
                float mv = val; int mi = e;
#pragma unroll
                for (int off = 16; off >= 1; off >>= 1) { const float ov = __shfl_xor(mv, off); const int oi = __shfl_xor(mi, off); if (ov > mv || (ov == mv && oi < mi)) { mv = ov; mi = oi; } }
                topv[k] = mv; topi[k] = mi; if (e == mi) val = -3.0e38f;
            }
            const float e1 = __expf(topv[1] - topv[0]), e2 = __expf(topv[2] - topv[0]), e3 = __expf(topv[3] - topv[0]);
            const float inv = 1.0f / (1.0f + e1 + e2 + e3);
            const float gk[4] = {inv, e1 * inv, e2 * inv, e3 * inv};
#pragma unroll
            for (int k = 0; k < 4; ++k) if (e == topi[k]) { const int lp = __hip_atomic_fetch_add(&lcnt[e], 1, __ATOMIC_RELAXED, __HIP_MEMORY_SCOPE_WORKGROUP); tsel[tl * 4 + k] = e | (lp << 8); tgate[tl * 4 + k] = gk[k]; }
        }
        __syncthreads();
        if (tid < 32 && rep == 0) { const int n = lcnt[tid]; lbase[tid] = n ? (int)__hip_atomic_fetch_add(gcnt + tid * 16, (unsigned)n, RLX_AGENT) : 0; }
        __syncthreads();
        if (tid < 256 && rep == 0) { const int tl = tid >> 2, k = tid & 3; const int se = tsel[tl * 4 + k]; const int e = se & 255, pos = lbase[e] + (se >> 8); const int tok = grp * 64 + tl;
            SEL[tok * 4 + k] = e; POS[tok * 4 + k] = pos; GATE[tok * 4 + k] = tgate[tl * 4 + k]; LIST[e * NTOK + pos] = tok; }
        __syncthreads();
        if (tid < 32) lcnt[tid] = 0;
        __syncthreads();
    }
}

DI MoeTab moe_tables(KA a, LAS unsigned char* lds, int layer, int tid) {
    LAS int* cb = (LAS int*)(lds + TAB_OFF); LAS int* cnt = cb + 64;
    unsigned* gcnt = (unsigned*)(a->ws + WS_CTL) + CW_CNT + layer * 32 * 16;
    __syncthreads();
    if (tid == 0) { int s = 0; for (int e = 0; e < 32; ++e) { const int n = (int)__hip_atomic_load(gcnt + e * 16, RLX_AGENT); cnt[e] = n; cb[e] = s; s += (n + 255) >> 8; } cb[32] = s; cb[33] = 0x7fffffff; }
    __syncthreads();
    const int G = gridDim.x, bx = blockIdx.x;
    MoeTab T; T.cb = cb; T.cnt = cnt; T.stage = (const LAS int*)(lds + MOE_STAGE_OFF);
    T.x = bx & 7; T.w = bx >> 3; T.nw = G >> 3;
    T.xq1 = cb[T.x + 1] - cb[T.x]; T.xq2 = T.xq1 + cb[T.x + 9] - cb[T.x + 8]; T.xq3 = T.xq2 + cb[T.x + 17] - cb[T.x + 16]; T.xq4 = T.xq3 + cb[T.x + 25] - cb[T.x + 24];
    return T;
}

DI void p10_combine(KA a, LAS unsigned char* lds, int layer, int tid, int lane, int wave, int vcu, int G) {
    const MoeTab T = moe_tables(a, lds, layer, tid);
    const float* MODV = (const float*)(a->ws + WS_MODV);
    const bf16* Y = (const bf16*)(a->ws + WS_Y);
    const int* SEL = (const int*)(a->ws + WS_SEL); const int* POS = (const int*)(a->ws + WS_POS); const float* GATE = (const float*)(a->ws + WS_GATE);
    bf16* XN = (bf16*)(a->ws + WS_XN); bf16* XKV = (bf16*)(a->ws + WS_XKV);
    float* hbuf = a->out;
    const int gw = vcu * 8 + wave, NGW = G * 8;
    const int nrep10 = (PROBE_PHASE == 110 && layer == 0) ? 2 : 1;
#pragma unroll 1
    for (int rep = 0; rep < nrep10; ++rep)
    for (int m = gw; m < NTOK; m += NGW) {
        const int b = m >> 11; const float* mod = MODV + (size_t)b * MODW;
        f32x4 v[4], s[4];
#pragma unroll
        for (int j = 0; j < 4; ++j) { v[j] = *((const f32x4*)(hbuf + (size_t)m * 1024) + lane + 64 * j); s[j] = (f32x4){0.f, 0.f, 0.f, 0.f}; }
#pragma unroll
        for (int k = 0; k < 4; ++k) {
            const int e = SEL[m * 4 + k]; const size_t slot = (size_t)T.cb[e] * 256 + POS[m * 4 + k]; const float gt = rep ? 0.f : GATE[m * 4 + k];
            const v2u* yr = (const v2u*)(Y + slot * 1024) + lane;
#pragma unroll
            for (int j = 0; j < 4; ++j) { const v2u w = yr[64 * j]; s[j][0] += gt * bflo(w[0]); s[j][1] += gt * bfhi(w[0]); s[j][2] += gt * bflo(w[1]); s[j][3] += gt * bfhi(w[1]); }
        }
#pragma unroll
        for (int j = 0; j < 4; ++j) { const f32x4 g2 = *(const f32x4*)(mod + layer * 6144 + 5 * 1024 + 4 * lane + 256 * j); v[j] = v[j] + g2 * s[j];
            *((f32x4*)(hbuf + (size_t)m * 1024) + lane + 64 * j) = v[j]; }
        if (layer == 0) {
            f32x4 t[4];
#pragma unroll
            for (int j = 0; j < 4; ++j) t[j] = v[j];
            modulate_row(t, mod + 12288, mod + 12288 + 1024, lane);
            store_bf16_row(XKV + (size_t)m * 1024, lane, t);
            modulate_row(v, mod + 6144, mod + 6144 + 1024, lane);
            store_bf16_row(XN + (size_t)m * 1024, lane, v);
        }
    }
}

DI void p12_attn_naive(KA a, LAS unsigned char* lds, int tid, int lane, int wave) {
    const bf16* QB = (const bf16*)(a->ws + WS_QB); const bf16* KSH = (const bf16*)(a->ws + WS_KSH); const bf16* VSH = (const bf16*)(a->ws + WS_VSH);
    bf16* ON = (bf16*)(a->ws + WS_ON);
    LAS float* Ks = (LAS float*)lds;
    LAS float* Vs = (LAS float*)(lds + 33792);
    LAS float* Ps = (LAS float*)(lds + 33792 + 32768);
    float lam;
    { float s1 = 0.f, s2 = 0.f; for (int i = 0; i < 64; ++i) { s1 += a->in[I_LQ1][i] * a->in[I_LK1][i]; s2 += a->in[I_LQ2][i] * a->in[I_LK2][i]; } lam = __expf(s1) - __expf(s2) + LAMBDA_INIT; }
    const int r = tid >> 3, p = tid & 7;
    for (int unit = blockIdx.x; unit < 2048; unit += gridDim.x) {
        const int b = unit >> 8, h = (unit >> 5) & 7, qc = unit & 31;
        const size_t tq = (size_t)b * SEQ + qc * 64 + r;
        float q0[64], q1[64];
        { const v4u* qp = (const v4u*)(QB + tq * 1024 + h * 128);
#pragma unroll
          for (int i = 0; i < 8; ++i) { const v4u w = qp[i], w1 = qp[8 + i];
#pragma unroll
              for (int j = 0; j < 4; ++j) { q0[8 * i + 2 * j] = bflo(w[j]); q0[8 * i + 2 * j + 1] = bfhi(w[j]); q1[8 * i + 2 * j] = bflo(w1[j]); q1[8 * i + 2 * j + 1] = bfhi(w1[j]); } } }
        float O0[16], O1[16], m0 = -1e30f, m1 = -1e30f, l0 = 0.f, l1 = 0.f;
#pragma unroll
        for (int i = 0; i < 16; ++i) { O0[i] = 0.f; O1[i] = 0.f; }
        for (int kt = 0; kt <= qc; ++kt) {
            __syncthreads();
            { const int j = tid >> 3, seg = (tid & 7) * 16; const size_t tk = (size_t)b * SEQ + kt * 64 + j;
              const v4u k0 = *(const v4u*)(KSH + tk * 1024 + h * 128 + seg), k1 = *(const v4u*)(KSH + tk * 1024 + h * 128 + seg + 8);
              const v4u v0 = *(const v4u*)(VSH + tk * 1024 + h * 128 + seg), v1 = *(const v4u*)(VSH + tk * 1024 + h * 128 + seg + 8);
#pragma unroll
              for (int i = 0; i < 4; ++i) { Ks[j * 132 + seg + 2 * i] = bflo(k0[i]); Ks[j * 132 + seg + 2 * i + 1] = bfhi(k0[i]); Ks[j * 132 + seg + 8 + 2 * i] = bflo(k1[i]); Ks[j * 132 + seg + 8 + 2 * i + 1] = bfhi(k1[i]);
                  Vs[j * 128 + seg + 2 * i] = bflo(v0[i]); Vs[j * 128 + seg + 2 * i + 1] = bfhi(v0[i]); Vs[j * 128 + seg + 8 + 2 * i] = bflo(v1[i]); Vs[j * 128 + seg + 8 + 2 * i + 1] = bfhi(v1[i]); } }
            __syncthreads();
            float s0[8], s1[8];
#pragma unroll
            for (int i = 0; i < 8; ++i) { const LAS float* kr = Ks + (p + 8 * i) * 132; float x0 = 0.f, x1 = 0.f;
#pragma unroll
                for (int d = 0; d < 64; d += 4) { const f32x4 ka = *(const LAS f32x4*)(kr + d), kb = *(const LAS f32x4*)(kr + 64 + d);
                    x0 += q0[d] * ka[0] + q0[d + 1] * ka[1] + q0[d + 2] * ka[2] + q0[d + 3] * ka[3];
                    x1 += q1[d] * kb[0] + q1[d + 1] * kb[1] + q1[d + 2] * kb[2] + q1[d + 3] * kb[3]; }
                s0[i] = x0; s1[i] = x1; }
            float mx0 = s0[0], mx1 = s1[0];
#pragma unroll
            for (int i = 1; i < 8; ++i) { mx0 = fmaxf(mx0, s0[i]); mx1 = fmaxf(mx1, s1[i]); }
#pragma unroll
            for (int off = 1; off <= 4; off <<= 1) { mx0 = fmaxf(mx0, __shfl_xor(mx0, off)); mx1 = fmaxf(mx1, __shfl_xor(mx1, off)); }
            const float mn0 = fmaxf(m0, mx0), mn1 = fmaxf(m1, mx1);
            const float al0 = __expf(m0 - mn0), al1 = __expf(m1 - mn1);
            float ps0 = 0.f, ps1 = 0.f;
#pragma unroll
            for (int i = 0; i < 8; ++i) { const float e0 = __expf(s0[i] - mn0), e1 = __expf(s1[i] - mn1); ps0 += e0; ps1 += e1;
                Ps[r * 65 + p + 8 * i] = e0; Ps[64 * 65 + r * 65 + p + 8 * i] = e1; }
#pragma unroll
            for (int off = 1; off <= 4; off <<= 1) { ps0 += __shfl_xor(ps0, off); ps1 += __shfl_xor(ps1, off); }
            l0 = l0 * al0 + ps0; l1 = l1 * al1 + ps1; m0 = mn0; m1 = mn1;
#pragma unroll
            for (int i = 0; i < 16; ++i) { O0[i] *= al0; O1[i] *= al1; }
            __syncthreads();
            for (int j = 0; j < 64; ++j) { const float pa = Ps[r * 65 + j], pb2 = Ps[64 * 65 + r * 65 + j]; const LAS float* vr = Vs + j * 128 + 16 * p;
#pragma unroll
                for (int c4 = 0; c4 < 16; c4 += 4) { const f32x4 vv = *(const LAS f32x4*)(vr + c4);
                    O0[c4] += pa * vv[0]; O0[c4 + 1] += pa * vv[1]; O0[c4 + 2] += pa * vv[2]; O0[c4 + 3] += pa * vv[3];
                    O1[c4] += pb2 * vv[0]; O1[c4 + 1] += pb2 * vv[1]; O1[c4 + 2] += pb2 * vv[2]; O1[c4 + 3] += pb2 * vv[3]; } }
        }
        const float i0 = 1.0f / l0, i1 = lam / l1; float o[16], ss = 0.f;
#pragma unroll
        for (int i = 0; i < 16; ++i) { o[i] = O0[i] * i0 - O1[i] * i1; ss += o[i] * o[i]; }
        ss += __shfl_xor(ss, 1); ss += __shfl_xor(ss, 2); ss += __shfl_xor(ss, 4);
        const float rn = rsqrtf(ss * (1.0f / 128.0f) + EPS) * (1.0f - LAMBDA_INIT);
        v4u w0, w1;
#pragma unroll
        for (int i = 0; i < 4; ++i) { w0[i] = pk2(o[2 * i] * rn * a->in[I_SUBLN][16 * p + 2 * i], o[2 * i + 1] * rn * a->in[I_SUBLN][16 * p + 2 * i + 1]);
            w1[i] = pk2(o[8 + 2 * i] * rn * a->in[I_SUBLN][16 * p + 8 + 2 * i], o[8 + 2 * i + 1] * rn * a->in[I_SUBLN][16 * p + 8 + 2 * i + 1]); }
        *(v4u*)(ON + tq * 1024 + h * 128 + 16 * p) = w0; *(v4u*)(ON + tq * 1024 + h * 128 + 16 * p + 8) = w1;
    }
}


constexpr int A_PK = 272, A_PV = 320, A_K = 0, A_V = 64 * A_PK, A_BUF = A_V + 64 * A_PV;
constexpr int A_X = 0;
DI void p12_attn(KA a, LAS unsigned char* lds, int tid, int lane, int wave, int vcu) {
    const bf16* QB = (const bf16*)(a->ws + WS_QB); const bf16* KSH = (const bf16*)(a->ws + WS_KSH); const bf16* VSH = (const bf16*)(a->ws + WS_VSH);
    bf16* ON = (bf16*)(a->ws + WS_ON);
    float lam;
    { const float s1 = wave_sum(a->in[I_LQ1][lane] * a->in[I_LK1][lane]), s2 = wave_sum(a->in[I_LQ2][lane] * a->in[I_LK2][lane]); lam = __expf(s1) - __expf(s2) + LAMBDA_INIT; }
    const int r32 = lane & 31, hh = lane >> 5, rg = wave >> 1, m = wave & 1;
    const int bh = vcu >> 2, jsel = vcu & 3, b = bh >> 3, h = bh & 7;
    const int srow0 = tid >> 4, scol = tid & 15;
    const float LOG2E = 1.4426950408889634f;
    if (bh >= 64) return;
    const int nui = (PROBE_PHASE == 120) ? 8 : 4;
#pragma unroll 1
    for (int ui8 = 0; ui8 < nui; ++ui8) { const int ui = ui8 & 3;
        const int qb = (ui == 0) ? jsel : (ui == 1) ? 7 - jsel : (ui == 2) ? 8 + jsel : 15 - jsel;
        const int ntile = 2 * qb + 2, myt = 2 * qb + 1 + (rg >> 1);
        const size_t tq = (size_t)b * SEQ + qb * 128 + rg * 32 + r32;
        bf16x8 Qf[4];
#pragma unroll
        for (int kk = 0; kk < 4; ++kk) Qf[kk] = *(const bf16x8*)(QB + tq * 1024 + h * 128 + 64 * m + 16 * kk + 8 * hh);
        f32x16 OT[4];
#pragma unroll
        for (int et = 0; et < 4; ++et)
#pragma unroll
            for (int i = 0; i < 16; ++i) OT[et][i] = 0.f;
        float mrun = -1.0e30f, lrun = 0.f;
        v4u rk[2], rv[2];
#define AT_LOAD(kt) do { const size_t tk = (size_t)b * SEQ + (kt) * 64; \
        _Pragma("unroll") for (int i = 0; i < 2; ++i) { const size_t go = (tk + srow0 + 32 * i) * 1024 + h * 128 + scol * 8; rk[i] = *(const v4u*)(KSH + go); rv[i] = *(const v4u*)(VSH + go); } } while (0)
#define AT_STORE(bufo) do { LAS unsigned char* B_ = lds + (bufo); \
        _Pragma("unroll") for (int i = 0; i < 2; ++i) { *(LAS v4u*)(B_ + A_K + (srow0 + 32 * i) * A_PK + scol * 16) = rk[i]; *(LAS v4u*)(B_ + A_V + (srow0 + 32 * i) * A_PV + scol * 16) = rv[i]; } } while (0)
        AT_LOAD(0); AT_STORE(0);
        __syncthreads();
        for (int kt = 0; kt < ntile; ++kt) {
            const LAS unsigned char* B = lds + (kt & 1) * A_BUF;
            if (kt + 1 < ntile) AT_LOAD(kt + 1);
            if (kt < myt) {
                f32x16 ST[2];
#pragma unroll
                for (int t = 0; t < 2; ++t) {
#pragma unroll
                    for (int i = 0; i < 16; ++i) ST[t][i] = 0.f;
                    const LAS unsigned char* kr = B + A_K + (32 * t + r32) * A_PK + (64 * m + 8 * hh) * 2;
#pragma unroll
                    for (int kk = 0; kk < 4; ++kk) ST[t] = __builtin_amdgcn_mfma_f32_32x32x16_bf16(*(const LAS bf16x8*)(kr + 32 * kk), Qf[kk], ST[t], 0, 0, 0);
                }
                float mx = ST[0][0];
#pragma unroll
                for (int t = 0; t < 2; ++t)
#pragma unroll
                    for (int i = 0; i < 16; ++i) mx = fmaxf(mx, ST[t][i]);
                mx = fmaxf(mx, __shfl_xor(mx, 32));
                const float mnew = fmaxf(mrun, mx * LOG2E);
                const float alpha = __builtin_amdgcn_exp2f(mrun - mnew);
                mrun = mnew;
                float ps = 0.f;
#pragma unroll
                for (int t = 0; t < 2; ++t)
#pragma unroll
                    for (int i = 0; i < 16; ++i) { const float pv = __builtin_amdgcn_exp2f(ST[t][i] * LOG2E - mnew); ST[t][i] = pv; ps += pv; }
                lrun = lrun * alpha + ps;
#pragma unroll
                for (int et = 0; et < 4; ++et)
#pragma unroll
                    for (int i = 0; i < 16; ++i) OT[et][i] *= alpha;
#pragma unroll
                for (int t = 0; t < 2; ++t)
#pragma unroll
                    for (int sp = 0; sp < 2; ++sp) {
                        v4u pw; pw.x = pg8::cvt_pk_bf16(ST[t][8 * sp], ST[t][8 * sp + 1]); pw.y = pg8::cvt_pk_bf16(ST[t][8 * sp + 2], ST[t][8 * sp + 3]);
                        pw.z = pg8::cvt_pk_bf16(ST[t][8 * sp + 4], ST[t][8 * sp + 5]); pw.w = pg8::cvt_pk_bf16(ST[t][8 * sp + 6], ST[t][8 * sp + 7]);
                        const bf16x8 pb = __builtin_bit_cast(bf16x8, pw);
                        const LAS unsigned char* vb = B + A_V + (32 * t + 16 * sp + 4 * hh + ((lane & 15) >> 2)) * A_PV + (16 * ((lane >> 4) & 1) + 4 * (lane & 3)) * 2;
#pragma unroll
                        for (int et = 0; et < 4; ++et) {
                            const s16x4 lo = lds_tr16_b64(vb + 64 * et), hi = lds_tr16_b64(vb + 64 * et + 8 * A_PV);
                            const bf16x8 va = __builtin_shufflevector(lo, hi, 0, 1, 2, 3, 4, 5, 6, 7);
                            OT[et] = __builtin_amdgcn_mfma_f32_32x32x16_bf16(va, pb, OT[et], 0, 0, 0);
                        }
                    }
            }
            if (kt + 1 < ntile) AT_STORE(((kt + 1) & 1) * A_BUF);
            __syncthreads();
        }
#undef AT_LOAD
#undef AT_STORE
        const float ltot = lrun + __shfl_xor(lrun, 32);
        const float sc = (m == 0) ? 1.0f / ltot : lam / ltot;
        LAS float* X = (LAS float*)(lds + A_X + rg * 16384);
        if (m == 1) {
#pragma unroll
            for (int et = 0; et < 4; ++et)
#pragma unroll
                for (int q4 = 0; q4 < 4; ++q4) { f32x4 v; v[0] = OT[et][4 * q4] * sc; v[1] = OT[et][4 * q4 + 1] * sc; v[2] = OT[et][4 * q4 + 2] * sc; v[3] = OT[et][4 * q4 + 3] * sc;
                    *(LAS f32x4*)(X + ((et * 4 + q4) * 64 + lane) * 4) = v; }
        }
        __syncthreads();
        if (m == 0) {
            float ss = 0.f;
#pragma unroll
            for (int et = 0; et < 4; ++et)
#pragma unroll
                for (int q4 = 0; q4 < 4; ++q4) { const f32x4 v = *(const LAS f32x4*)(X + ((et * 4 + q4) * 64 + lane) * 4);
#pragma unroll
                    for (int i = 0; i < 4; ++i) { const float o = OT[et][4 * q4 + i] * sc - v[i]; OT[et][4 * q4 + i] = o; ss += o * o; } }
            ss += __shfl_xor(ss, 32);
            const float rn = rsqrtf(ss * (1.0f / 128.0f) + EPS) * (1.0f - LAMBDA_INIT);
            asm volatile("s_waitcnt lgkmcnt(0)" ::: "memory");
            LAS unsigned char* T = (LAS unsigned char*)X;
#pragma unroll
            for (int et = 0; et < 4; ++et)
#pragma unroll
                for (int q4 = 0; q4 < 4; ++q4) { const int e0 = 32 * et + 8 * q4 + 4 * hh; const f32x4 sw = *(const f32x4*)(a->in[I_SUBLN] + e0);
                    v2u w; w.x = pk2(OT[et][4 * q4] * rn * sw[0], OT[et][4 * q4 + 1] * rn * sw[1]); w.y = pk2(OT[et][4 * q4 + 2] * rn * sw[2], OT[et][4 * q4 + 3] * rn * sw[3]);
                    *(LAS v2u*)(T + r32 * 272 + e0 * 2) = w; }
            asm volatile("s_waitcnt lgkmcnt(0)" ::: "memory");
            const size_t trow = (size_t)b * SEQ + qb * 128 + rg * 32;
#pragma unroll
            for (int i = 0; i < 8; ++i) { const int ch = lane + 64 * i, row = ch >> 4, c16 = ch & 15;
                *(v4u*)(ON + (trow + row) * 1024 + h * 128 + c16 * 8) = *(const LAS v4u*)(T + row * 272 + c16 * 16); }
        }
        __syncthreads();
    }
}

__global__ void __launch_bounds__(512, 2) fwd(Args a_by_value) {
    extern __shared__ __attribute__((aligned(16))) unsigned char lds_raw[];
    LAS unsigned char* lds = (LAS unsigned char*)lds_raw;
    const int tid = threadIdx.x;
    KA a = launder_args();
    const int G = gridDim.x; const int bx = blockIdx.x; const int vcu = (G % 8 == 0) ? (bx % 8) * (G / 8) + bx / 8 : bx;
    unsigned* ctl = (unsigned*)(a->ws + WS_CTL);
    for (int u = tid; u < (LDS_BYTES - LDSCTL_OFF) / 4; u += 512) ((LAS unsigned*)(lds + LDSCTL_OFF))[u] = 0u;
    __syncthreads();
    XcdBarrier bar; bar.bar = ctl + CW_BAR; bar.x = 0; bar.st = nullptr;
    const bool one_launch = (a->ph_hi - a->ph_lo) > 1;
    if (one_launch) bar = xcd_barrier_post(ctl + CW_BAR, (volatile LAS unsigned*)(lds + MISC_OFF) + 8);
    const int lo = a->ph_lo, hi = a->ph_hi;
#ifndef PHMASK
#define PHMASK 0xFFFFFFFFu
#endif
#define IN(k) ((((PHMASK) >> (k)) & 1u) && lo <= (k) && (k) < hi)
#define REP(k) for (int rep_ = 0; rep_ < ((k) == PROBE_PHASE ? 2 : 1); ++rep_, (((k) == PROBE_PHASE) ? __syncthreads() : (void)0))
#define SEAM(k) do { if (IN(k) && IN((k) + 1)) xcd_barrier(bar); } while (0)
#define SEAM_BG(k, need) do { if (IN(k) && IN((k) + 1)) { KA a = launder_args(); bg_convert(a, lds, (need), (k), G); xcd_barrier(bar); } } while (0)
    unsigned char* ws = a->ws;

#define PH_IDS KA a = launder_args(); const int tid = fresh_tid(), lane = tid & 63, wave = __builtin_amdgcn_readfirstlane(tid >> 6); (void)tid; (void)lane; (void)wave
    if (IN(0)) REP(0) { PH_IDS; p0_modvec(a, lds, tid, lane, wave); p0_convert(a, lds, lane, wave, vcu, G); }
    SEAM(0);
    if (IN(1)) REP(1) { PH_IDS; p1_norm1(a, lds, tid, lane, wave, vcu, G); }
    SEAM(1);
    if (IN(2)) REP(2) { PInProj P; P.A = (const char*)(ws + WS_XN); P.B = (const char*)(ws + WS_WIN); P.O = (bf16*)(ws + WS_PROJ); P.S.init(NTOK, 4096, G, bx);
        pg8::gemm_phase<PInProj, true>(lds, P); }
    SEAM(2);
#if DELTA_NAIVE
    if (IN(3)) REP(3) { PH_IDS; p3_delta_naive(a, lds, tid, lane, wave); }
    SEAM(3);
    SEAM(4);
#else
    if (IN(3)) REP(3) { PH_IDS; p3_chunk_local(a, lds, tid, lane, wave, vcu, G); }
    SEAM_BG(3, 0);
    if (IN(4)) REP(4) { PH_IDS; p4_recurrence(a, lds, tid, lane, wave); }
    SEAM_BG(4, 0);
#endif
    if (IN(5)) REP(5) { PH_IDS; p5_gated_norm(a, lane, wave, vcu, G); }
    SEAM(5);
    if (IN(6)) REP(6) { POutProj P; P.A = (const char*)(ws + WS_ON); P.B = (const char*)(ws + WS_WOA); P.base = a->in[I_X]; P.out = a->out; P.gvec = (const float*)(ws + WS_MODV) + 2 * 1024; P.S.init(NTOK, 1024, G, bx);
        pg8::gemm_phase<POutProj, false>(lds, P); }
    SEAM(6);
    if (IN(7)) REP(7) { PH_IDS; p7_router(a, lds, 0, tid, lane, wave, vcu, G); }
    SEAM_BG(7, NQ_L0);
    if (IN(8)) REP(8) { PH_IDS; PMoe1 P; P.A = (const char*)(ws + WS_XN); P.B = (const char*)(ws + WS_WGU); P.HID = (bf16*)(ws + WS_HID); P.list = (const int*)(ws + WS_LIST);
        P.bg = a->in[I_BG]; P.bu = a->in[I_BU]; P.T = moe_tables(a, lds, 0, tid); P.stage_units(tid);
        pg8::gemm_phase<PMoe1, true>(lds, P); }
    SEAM_BG(8, 0);
    if (IN(9)) REP(9) { PH_IDS; PMoe2 P; P.A = (const char*)(ws + WS_HID); P.B = (const char*)(ws + WS_WD); P.Y = (bf16*)(ws + WS_Y); P.bd = a->in[I_BDN]; P.T = moe_tables(a, lds, 0, tid); P.stage_units(tid);
        pg8::gemm_phase<PMoe2, true>(lds, P); }
    SEAM_BG(9, 0);
    if (IN(10)) REP(10) { PH_IDS; p10_combine(a, lds, 0, tid, lane, wave, vcu, G); }
    SEAM_BG(10, NQ_ATT);
    if (IN(11)) REP(11) { PKVQ P; P.ws = ws; P.knorm = a->in[I_BKNORM]; P.qnorm = a->in[I_BQNORM]; P.S.init(NTOK, 3072, G, bx);
        pg8::gemm_phase<PKVQ, true>(lds, P); }
    SEAM_BG(11, 0);
#if ATTN_NAIVE
    if (IN(12)) REP(12) { PH_IDS; p12_attn_naive(a, lds, tid, lane, wave); }
#else
    if (IN(12)) REP(12) { PH_IDS; p12_attn(a, lds, tid, lane, wave, vcu); }
#endif
    SEAM_BG(12, 0);
    if (IN(13)) REP(13) { POutProj P; P.A = (const char*)(ws + WS_ON); P.B = (const char*)(ws + WS_WOB); P.base = a->out; P.out = a->out; P.gvec = (const float*)(ws + WS_MODV) + 6144 + 2 * 1024; P.S.init(NTOK, 1024, G, bx);
        pg8::gemm_phase<POutProj, false>(lds, P); }
    SEAM(13);
    if (IN(14)) REP(14) { PH_IDS; p7_router(a, lds, 1, tid, lane, wave, vcu, G); }
    SEAM_BG(14, NQ_ALL);
    if (IN(15)) REP(15) { PH_IDS; PMoe1 P; P.A = (const char*)(ws + WS_XN); P.B = (const char*)(ws + WS_WGU) + (size_t)32 * 2048 * 2048; P.HID = (bf16*)(ws + WS_HID); P.list = (const int*)(ws + WS_LIST);
        P.bg = a->in[I_BG] + 32 * 1024; P.bu = a->in[I_BU] + 32 * 1024; P.T = moe_tables(a, lds, 1, tid); P.stage_units(tid);
        pg8::gemm_phase<PMoe1, true>(lds, P); }
    SEAM(15);
    if (IN(16)) REP(16) { PH_IDS; PMoe2 P; P.A = (const char*)(ws + WS_HID); P.B = (const char*)(ws + WS_WD) + (size_t)32 * 1024 * 2048; P.Y = (bf16*)(ws + WS_Y); P.bd = a->in[I_BDN] + 32 * 1024; P.T = moe_tables(a, lds, 1, tid); P.stage_units(tid);
        pg8::gemm_phase<PMoe2, true>(lds, P); }
    SEAM(16);
    if (IN(17)) REP(17) { PH_IDS; p10_combine(a, lds, 1, tid, lane, wave, vcu, G); }
#undef IN
#undef SEAM
}

extern "C" void kernel_launch(void* const* d_in, const int* in_sizes, int n_in, void* d_out, int out_size, void* d_ws, size_t ws_size, hipStream_t stream) {
    static int grid = 0;
    if (grid == 0) {
        if (n_in != 31 || out_size != NTOK * D || ws_size < WS_END) { fprintf(stderr, "kernel_launch: unexpected shapes (n_in %d out %d ws %zu)\n", n_in, out_size, ws_size); grid = -1; return; }
        int dev = 0, cus = 0, per_cu = 0;
        if (hipGetDevice(&dev) != hipSuccess || hipDeviceGetAttribute(&cus, hipDeviceAttributeMultiprocessorCount, dev) != hipSuccess) { grid = -1; return; }
        if (hipFuncSetAttribute((const void*)fwd, hipFuncAttributeMaxDynamicSharedMemorySize, LDS_BYTES) != hipSuccess) { fprintf(stderr, "kernel_launch: hipFuncSetAttribute failed\n"); grid = -1; return; }
        if (hipOccupancyMaxActiveBlocksPerMultiprocessor(&per_cu, (const void*)fwd, 512, LDS_BYTES) != hipSuccess || per_cu < 1) fprintf(stderr, "kernel_launch: occupancy query says %d\n", per_cu);
        (void)hipGetLastError();
        grid = cus;
    }
    if (grid < 0) return;
    (void)hipMemsetAsync((char*)d_ws + WS_CTL, 0, CTL_ZERO_BYTES, stream);
    Args a{};
    for (int i = 0; i < 31; ++i) a.in[i] = (const float*)d_in[i];
    a.out = (float*)d_out; a.ws = (unsigned char*)d_ws;
#if MK_PER_PHASE
    for (int p = 0; p < NPHASE; ++p) {
        if (p == 4 && DELTA_NAIVE) continue;
        a.ph_lo = p; a.ph_hi = p + 1;
        hipLaunchKernelGGL(fwd, dim3(grid), dim3(512), LDS_BYTES, stream, a);
    }
#else
    a.ph_lo = 0; a.ph_hi = NPHASE;
    hipLaunchKernelGGL(fwd, dim3(grid), dim3(512), LDS_BYTES, stream, a);
#endif
}
```
